# Optimizing an MI355X kernel written in HIP

```python
import jax, jax.numpy as jnp
from jax import lax
import numpy as np

D_MODEL = 1024
BATCH = 8
SEQ = 2048
DEPTH = 4

N_MIXERS = 3
HEAD_DIM = 64
ROPE_THETA = 10000.0
RMS_EPS = 1e-6
NEG_INF = -1e30
GRID_W = 64

A_HEADS = D_MODEL // HEAD_DIM
A_GROUPS = ((128, 1), (512, 4), (2048, 16))
A_QBLOCK = 64
A_WIDTH = A_HEADS * HEAD_DIM

B_HEADS = D_MODEL // HEAD_DIM
NA_KH = 8
NA_KW = 16
NA_QCOLS = 16
NA_KCOLS = 32
B_WIDTH = B_HEADS * HEAD_DIM

C_Q_HEADS = D_MODEL // HEAD_DIM
C_KV_HEADS = 4
C_QBLOCK = 128
C_WIDTH = C_Q_HEADS * HEAD_DIM

D_FF = 4 * D_MODEL

kernel_name = "interleaved_dilated_neighbourhood_gqa_encoder"


def rms_norm(x, g):
    xf = x.astype(jnp.float32)
    y = xf * lax.rsqrt(jnp.mean(xf * xf, axis=-1, keepdims=True) + RMS_EPS)
    return (y * g.astype(jnp.float32)).astype(x.dtype)


def rope_angles(pos, dim):
    inv = 1.0 / (ROPE_THETA ** (jnp.arange(0, dim, 2, dtype=jnp.float32) / dim))
    return pos.astype(jnp.float32)[:, None] * inv[None, :]


def apply_rope(x, cos, sin):
    xf = x.astype(jnp.float32)
    x1, x2 = jnp.split(xf, 2, axis=-1)
    c = cos[:, None, :]
    s = sin[:, None, :]
    return jnp.concatenate([x1 * c - x2 * s, x2 * c + x1 * s], axis=-1).astype(x.dtype)


def dilated_group(q, k, v, dilation, half):
    B, S, H, Dh = q.shape
    L = S // dilation
    nb = -(-L // A_QBLOCK)
    Lp = nb * A_QBLOCK
    span_blocks = 1 + (2 * half) // A_QBLOCK
    span = span_blocks * A_QBLOCK
    qs = q.reshape(B, L, dilation, H, Dh)
    ks = k.reshape(B, L, dilation, H, Dh)
    vs = v.reshape(B, L, dilation, H, Dh)
    pad_q = ((0, 0), (0, Lp - L), (0, 0), (0, 0), (0, 0))
    pad_k = ((0, 0), (half, Lp - L + half), (0, 0), (0, 0), (0, 0))
    qb = jnp.pad(qs, pad_q).reshape(B, nb, A_QBLOCK, dilation, H, Dh)
    kb = jnp.pad(ks, pad_k).reshape(B, nb + span_blocks - 1, A_QBLOCK, dilation, H, Dh)
    vb = jnp.pad(vs, pad_k).reshape(B, nb + span_blocks - 1, A_QBLOCK, dilation, H, Dh)
    kw = jnp.concatenate([kb[:, s:s + nb] for s in range(span_blocks)], axis=2)
    vw = jnp.concatenate([vb[:, s:s + nb] for s in range(span_blocks)], axis=2)
    qi = np.arange(nb)[:, None, None] * A_QBLOCK + np.arange(A_QBLOCK)[None, :, None]
    kj = np.arange(nb)[:, None, None] * A_QBLOCK + np.arange(span)[None, None, :] - half
    mask = (kj >= 0) & (kj < L) & (np.abs(qi - kj) <= half)
    scale = Dh ** -0.5
    s = jnp.einsum('bnqrhe,bnkrhe->brhnqk', qb, kw, preferred_element_type=jnp.float32) * scale
    s = jnp.where(mask, s, NEG_INF)
    m = jnp.max(s, axis=-1, keepdims=True)
    p = jnp.exp(s - m)
    den = jnp.sum(p, axis=-1)
    o = jnp.einsum('brhnqk,bnkrhe->bnqrhe', p.astype(v.dtype), vw, preferred_element_type=jnp.float32)
    o = o / den.transpose(0, 3, 4, 1, 2)[..., None]
    lse = (m[..., 0] + jnp.log(den)).transpose(0, 3, 4, 1, 2)
    o = o.reshape(B, Lp, dilation, H, Dh)[:, :L].reshape(B, S, H, Dh)
    lse = lse.reshape(B, Lp, dilation, H)[:, :L].reshape(B, S, H)
    return o, lse


def mixer_a(h, w_in, w_out, cos, sin):
    B, S, _ = h.shape
    proj = (h @ w_in).reshape(B, S, len(A_GROUPS), 3, A_HEADS, HEAD_DIM)
    outs, lses = [], []
    for g, (window, dilation) in enumerate(A_GROUPS):
        q = apply_rope(proj[:, :, g, 0], cos, sin)
        k = apply_rope(proj[:, :, g, 1], cos, sin)
        v = proj[:, :, g, 2]
        o, lse = dilated_group(q, k, v, dilation, window // (2 * dilation))
        outs.append(o)
        lses.append(lse)
    wts = jax.nn.softmax(jnp.stack(lses, axis=0), axis=0)
    o = jnp.sum(wts[..., None] * jnp.stack(outs, axis=0), axis=0)
    return o.reshape(B, S, A_WIDTH).astype(h.dtype) @ w_out


def mixer_b(h, w_in, rpb, w_out):
    B, S, _ = h.shape
    rows = S // GRID_W
    kh = min(NA_KH, rows)
    qkv = (h @ w_in).reshape(B, rows, GRID_W, 3, B_HEADS, HEAD_DIM)
    q, k, v = qkv[:, :, :, 0], qkv[:, :, :, 1], qkv[:, :, :, 2]
    nqb = GRID_W // NA_QCOLS
    qc = np.arange(GRID_W).reshape(nqb, NA_QCOLS)
    kstart = np.clip(np.arange(nqb) * NA_QCOLS - (NA_KCOLS - NA_QCOLS) // 2, 0, GRID_W - NA_KCOLS)
    kc = kstart[:, None] + np.arange(NA_KCOLS)[None, :]
    cs = np.clip(qc - NA_KW // 2, 0, GRID_W - NA_KW)
    col_mask = (kc[:, None, :] >= cs[:, :, None]) & (kc[:, None, :] < cs[:, :, None] + NA_KW)
    dcol_idx = np.clip(kc[:, None, :] - qc[:, :, None] + NA_KW - 1, 0, 2 * NA_KW - 2)
    col_bias = rpb[:, :, dcol_idx]
    scale = HEAD_DIM ** -0.5

    def row_fn(r):
        rs = jnp.clip(r - kh // 2, 0, rows - kh)
        k_rows = lax.dynamic_slice_in_dim(k, rs, kh, axis=1)
        v_rows = lax.dynamic_slice_in_dim(v, rs, kh, axis=1)
        q_row = lax.dynamic_index_in_dim(q, r, axis=1, keepdims=False)
        q_cb = q_row.reshape(B, nqb, NA_QCOLS, B_HEADS, HEAD_DIM)
        k_cb = jnp.stack([k_rows[:, :, int(s0):int(s0) + NA_KCOLS] for s0 in kstart], axis=1)
        v_cb = jnp.stack([v_rows[:, :, int(s0):int(s0) + NA_KCOLS] for s0 in kstart], axis=1)
        s = jnp.einsum('bjqhd,bjakhd->bhjqak', q_cb, k_cb, preferred_element_type=jnp.float32) * scale
        drow_idx = rs + jnp.arange(kh) - r + NA_KH - 1
        bias = col_bias[:, drow_idx].transpose(0, 2, 3, 1, 4)
        s = s + bias[None].astype(jnp.float32)
        s = jnp.where(col_mask[:, :, None, :], s, NEG_INF)
        p = jax.nn.softmax(s.reshape(B, B_HEADS, nqb, NA_QCOLS, kh * NA_KCOLS), axis=-1)
        o = jnp.einsum('bhjqn,bjnhd->bjqhd', p.astype(v.dtype),
                       v_cb.reshape(B, nqb, kh * NA_KCOLS, B_HEADS, HEAD_DIM))
        return o.reshape(B, GRID_W, B_HEADS, HEAD_DIM)

    out = lax.map(row_fn, jnp.arange(rows, dtype=jnp.int32))
    out = out.transpose(1, 0, 2, 3, 4).reshape(B, S, B_WIDTH)
    return out @ w_out


def mixer_c(h, w_in, q_norm, k_norm, w_out, cos, sin):
    B, S, _ = h.shape
    G = C_Q_HEADS // C_KV_HEADS
    proj = h @ w_in
    nq = C_Q_HEADS * HEAD_DIM
    nk = C_KV_HEADS * HEAD_DIM
    q = proj[..., :nq].reshape(B, S, C_Q_HEADS, HEAD_DIM)
    k = proj[..., nq:nq + nk].reshape(B, S, C_KV_HEADS, HEAD_DIM)
    v = proj[..., nq + nk:].reshape(B, S, C_KV_HEADS, HEAD_DIM)
    q = apply_rope(rms_norm(q, q_norm), cos, sin)
    k = apply_rope(rms_norm(k, k_norm), cos, sin)
    nqb = S // C_QBLOCK
    qb = q.reshape(B, nqb, C_QBLOCK, C_KV_HEADS, G, HEAD_DIM).transpose(1, 0, 2, 3, 4, 5)
    scale = HEAD_DIM ** -0.5

    def block_fn(qblk):
        s = jnp.einsum('bqkgd,bskd->bkgqs', qblk, k, preferred_element_type=jnp.float32) * scale
        p = jax.nn.softmax(s, axis=-1)
        return jnp.einsum('bkgqs,bskd->bqkgd', p.astype(v.dtype), v)

    out = lax.map(block_fn, qb)
    out = out.transpose(1, 0, 2, 3, 4, 5).reshape(B, S, C_WIDTH)
    return out @ w_out


def squared_relu_mlp(h, w_up, w_down):
    u = h @ w_up
    return jnp.square(jax.nn.relu(u)) @ w_down


def setup_inputs(seed: int = 0) -> dict:
    key = jax.random.key(seed)
    ks = iter(jax.random.split(key, 10 * DEPTH + 4))

    def nrm(shape, scale):
        return jax.random.normal(next(ks), shape, jnp.float32) * scale

    def gain(n):
        return 1.0 + nrm((n,), 0.05)

    p = {"x": nrm((BATCH, SEQ, D_MODEL), 1.0)}
    for i in range(DEPTH):
        kind = i % N_MIXERS
        p[f"l{i}_attn_norm"] = gain(D_MODEL)
        if kind == 0:
            p[f"l{i}_w_in"] = nrm((D_MODEL, len(A_GROUPS) * 3 * A_WIDTH), D_MODEL ** -0.5)
            p[f"l{i}_w_out"] = nrm((A_WIDTH, D_MODEL), A_WIDTH ** -0.5)
        elif kind == 1:
            p[f"l{i}_w_in"] = nrm((D_MODEL, 3 * B_WIDTH), D_MODEL ** -0.5)
            p[f"l{i}_rpb"] = nrm((B_HEADS, 2 * NA_KH - 1, 2 * NA_KW - 1), 0.1)
            p[f"l{i}_w_out"] = nrm((B_WIDTH, D_MODEL), B_WIDTH ** -0.5)
        else:
            p[f"l{i}_w_in"] = nrm((D_MODEL, (C_Q_HEADS + 2 * C_KV_HEADS) * HEAD_DIM), D_MODEL ** -0.5)
            p[f"l{i}_q_norm"] = gain(HEAD_DIM)
            p[f"l{i}_k_norm"] = gain(HEAD_DIM)
            p[f"l{i}_w_out"] = nrm((C_WIDTH, D_MODEL), C_WIDTH ** -0.5)
        p[f"l{i}_mlp_norm"] = gain(D_MODEL)
        p[f"l{i}_w_up"] = nrm((D_MODEL, D_FF), D_MODEL ** -0.5)
        p[f"l{i}_w_down"] = nrm((D_FF, D_MODEL), D_FF ** -0.5)
    p["final_norm"] = gain(D_MODEL)
    return p


def reference(x,
              l0_attn_norm, l0_w_in, l0_w_out, l0_mlp_norm, l0_w_up, l0_w_down,
              l1_attn_norm, l1_w_in, l1_rpb, l1_w_out, l1_mlp_norm, l1_w_up, l1_w_down,
              l2_attn_norm, l2_w_in, l2_q_norm, l2_k_norm, l2_w_out, l2_mlp_norm, l2_w_up, l2_w_down,
              l3_attn_norm, l3_w_in, l3_w_out, l3_mlp_norm, l3_w_up, l3_w_down,
              final_norm):
    S = x.shape[1]
    t = jnp.arange(S, dtype=jnp.int32)
    ang_a = rope_angles(t, HEAD_DIM)
    ang_c = jnp.concatenate([rope_angles(t // GRID_W, HEAD_DIM // 2),
                             rope_angles(t % GRID_W, HEAD_DIM // 2)], axis=-1)
    cos_a, sin_a = jnp.cos(ang_a), jnp.sin(ang_a)
    cos_c, sin_c = jnp.cos(ang_c), jnp.sin(ang_c)

    attn_norms = (l0_attn_norm, l1_attn_norm, l2_attn_norm, l3_attn_norm)
    mixer_params = ((l0_w_in, l0_w_out),
                    (l1_w_in, l1_rpb, l1_w_out),
                    (l2_w_in, l2_q_norm, l2_k_norm, l2_w_out),
                    (l3_w_in, l3_w_out))
    mlp_norms = (l0_mlp_norm, l1_mlp_norm, l2_mlp_norm, l3_mlp_norm)
    w_ups = (l0_w_up, l1_w_up, l2_w_up, l3_w_up)
    w_downs = (l0_w_down, l1_w_down, l2_w_down, l3_w_down)

    for i in range(DEPTH):
        kind = i % N_MIXERS
        h = rms_norm(x, attn_norms[i])
        if kind == 0:
            y = mixer_a(h, *mixer_params[i], cos_a, sin_a)
        elif kind == 1:
            y = mixer_b(h, *mixer_params[i])
        else:
            y = mixer_c(h, *mixer_params[i], cos_c, sin_c)
        x = x + y
        x = x + squared_relu_mlp(rms_norm(x, mlp_norms[i]), w_ups[i], w_downs[i])
    return rms_norm(x, final_norm)
```

```cpp
#include <hip/hip_runtime.h>
#include <cstdio>
#include <cstdint>
namespace pg8 {
#define PG8_LAS __attribute__((address_space(3)))
typedef unsigned short bf16_t;
typedef short bf16x8 __attribute__((ext_vector_type(8)));
typedef float f32x4 __attribute__((ext_vector_type(4)));
typedef unsigned u32x4 __attribute__((ext_vector_type(4)));
constexpr int BM = 256, BK = 64, HALF = 128, HTB = HALF * BK * 2  , STAGE_BYTES = 8 * HTB, NXCD = 8, WGM = 8;

__host__ __device__ __forceinline__ int lds_byte(int r, int c) { const int st = (r >> 4) * 2 + (c >> 5), rr = r & 15, cc = c & 31, ob = rr * 64 + cc * 2; return st * 1024 + (ob ^ (((ob >> 9) & 1) << 5)); }
__host__ __device__ __forceinline__ void stage_rc(int b, int& R, int& C) { const int st = b / 1024, sb = b % 1024, swz = sb ^ (((sb >> 9) & 1) << 5); R = (st >> 1) * 16 + swz / 64; C = (st & 1) * 32 + (swz % 64) / 2; }
__host__ __device__ __forceinline__ int perm32(int rho) { const int n = rho >> 4, i = rho & 15; return 8 * (i >> 2) + 4 * n + (i & 3); }

struct Unit { int pm, pn; };
struct Gemm { const bf16_t* A; const bf16_t* Bt; int M, N, K; };

struct StaticOrder {
    int nM, nN, nwg, G, c;
    __host__ __device__ void init(int M, int N, int G_, int c_) { nM = M / BM; nN = N / BM; nwg = nM * nN; G = G_; c = c_; }
    __host__ __device__ bool next(int i, Unit& u) const {
        const long L = (long)i * G + c; if (L >= nwg) return false;
        int wgid = (int)L; { const int q = nwg / NXCD, r = nwg % NXCD, xcd = wgid % NXCD, off = wgid / NXCD; wgid = (xcd < r ? xcd * (q + 1) : r * (q + 1) + (xcd - r) * q) + off; }
        const int nig = WGM * nN, gid = wgid / nig, fm = gid * WGM, gsz = (nM - fm) < WGM ? (nM - fm) : WGM;
        u.pm = fm + ((wgid % nig) % gsz); u.pn = (wgid % nig) / gsz; return true;
    }
    __device__ __forceinline__ void a_ready(const Unit&) const {}
    __device__ __forceinline__ void done(const Unit&) const {}
};


__device__ __forceinline__ unsigned cvt_pk_bf16(float lo, float hi) { unsigned r; asm volatile("v_cvt_pk_bf16_f32 %0, %1, %2" : "=v"(r) : "v"(lo), "v"(hi)); return r; }
typedef unsigned u32x2 __attribute__((ext_vector_type(2)));
constexpr float QSCALE = 0.125f * 1.4426950408889634f;
constexpr float RMS_EPS = 1e-6f;
__device__ __forceinline__ float row_rstd(const float* rss, int row) {
    const f32x4* p = (const f32x4*)(rss + (size_t)row * 16);
    const f32x4 a = p[0], b = p[1], c = p[2], d = p[3];
    const f32x4 s = (a + b) + (c + d);
    const float ss = (s[0] + s[1]) + (s[2] + s[3]);
    return __builtin_amdgcn_rsqf(ss * (1.0f / 1024.0f) + RMS_EPS);
}
template <int KIND> struct EpiQKV {
    static constexpr bool PERM = true, AFTER_DRAIN = false;
    bf16_t* O; int ldc; const float* rss; const float* cosT; const float* sinT; const float* qg; const float* kg;
    __device__ __forceinline__ void operator()(const f32x4 (&acc)[2][2][4][2], const Unit& u, int wr, int wc, int fr, int fq) const {
        const int tcol = u.pn * BM;
        int sec;
        if (KIND == 2) sec = tcol < 1024 ? 0 : (tcol == 1024 ? 1 : 2); else sec = tcol >> 10;
        const int row0 = u.pm * BM + wr * 64 + fr;
        const int lc0 = tcol + 64 * wc + 8 * fq;
        const bool do_rope = (KIND != 1) && sec < 2;
        const bool do_hn = (KIND == 2) && sec < 2;
        const float qs = (sec == 0) ? QSCALE : 1.0f;
        f32x4 g[2][2];
#pragma unroll
        for (int bj = 0; bj < 2; ++bj)
#pragma unroll
            for (int n = 0; n < 2; ++n) g[bj][n] = (f32x4){1.f, 1.f, 1.f, 1.f};
        if (do_hn) { const float* gp = sec == 0 ? qg : kg;
#pragma unroll
            for (int bj = 0; bj < 2; ++bj)
#pragma unroll
                for (int n = 0; n < 2; ++n) g[bj][n] = *(const f32x4*)(gp + 32 * bj + 8 * fq + 4 * n); }
#pragma unroll
        for (int ai = 0; ai < 2; ++ai)
#pragma unroll
            for (int m = 0; m < 4; ++m) {
                const int row = row0 + ai * HALF + m * 16;
                const float rstd = row_rstd(rss, row);
                f32x4 v[2][2];
#pragma unroll
                for (int bj = 0; bj < 2; ++bj)
#pragma unroll
                    for (int n = 0; n < 2; ++n) v[bj][n] = acc[ai][bj][m][n] * rstd;
                if (do_hn) {
                    float ss = 0.f;
#pragma unroll
                    for (int bj = 0; bj < 2; ++bj)
#pragma unroll
                        for (int n = 0; n < 2; ++n) { const f32x4 x = v[bj][n]; ss += (x[0] * x[0] + x[1] * x[1]) + (x[2] * x[2] + x[3] * x[3]); }
                    ss += __shfl_xor(ss, 16); ss += __shfl_xor(ss, 32);
                    const float r2 = __builtin_amdgcn_rsqf(ss * (1.0f / 64.0f) + RMS_EPS);
#pragma unroll
                    for (int bj = 0; bj < 2; ++bj)
#pragma unroll
                        for (int n = 0; n < 2; ++n) v[bj][n] = v[bj][n] * r2 * g[bj][n];
                }
                if (do_rope) {
                    const int pos = row & 2047;
#pragma unroll
                    for (int n = 0; n < 2; ++n) {
                        const f32x4 c = *(const f32x4*)(cosT + pos * 32 + 8 * fq + 4 * n), s = *(const f32x4*)(sinT + pos * 32 + 8 * fq + 4 * n);
                        const f32x4 x1 = v[0][n], x2 = v[1][n];
                        v[0][n] = x1 * c - x2 * s; v[1][n] = x2 * c + x1 * s;
                    }
                }
                bf16_t* rowp = O + (size_t)row * ldc + lc0;
#pragma unroll
                for (int bj = 0; bj < 2; ++bj) {
                    const f32x4 v0 = v[bj][0] * qs, v1 = v[bj][1] * qs;
                    u32x4 w; w.x = cvt_pk_bf16(v0[0], v0[1]); w.y = cvt_pk_bf16(v0[2], v0[3]); w.z = cvt_pk_bf16(v1[0], v1[1]); w.w = cvt_pk_bf16(v1[2], v1[3]);
                    *(u32x4*)(rowp + 32 * bj) = w;
                }
            }
    }
};
struct EpiRes {
    static constexpr bool PERM = false, AFTER_DRAIN = true;
    const float* xin; float* xout; bf16_t* xb; float* rss;
    __device__ __forceinline__ void fused(const f32x4 (&acc)[2][2][4][2], const Unit& u, int wr, int wc, int fr, int fq, PG8_LAS unsigned char*, int, int) const {
        const int row0 = u.pm * BM + wr * 64 + fr, col0 = u.pn * BM + wc * 32 + 4 * fq;
#pragma unroll
        for (int ai = 0; ai < 2; ++ai)
#pragma unroll
            for (int m = 0; m < 4; ++m) {
                const int row = row0 + ai * HALF + m * 16; float ss = 0.f;
#pragma unroll
                for (int bj = 0; bj < 2; ++bj)
#pragma unroll
                    for (int n = 0; n < 2; ++n) {
                        const size_t off = (size_t)row * 1024 + col0 + bj * HALF + n * 16;
                        const f32x4 xv = *(const f32x4*)(xin + off) + acc[ai][bj][m][n];
                        *(f32x4*)(xout + off) = xv;
                        u32x2 w; w.x = cvt_pk_bf16(xv[0], xv[1]); w.y = cvt_pk_bf16(xv[2], xv[3]);
                        *(u32x2*)(xb + off) = w;
                        ss += (xv[0] * xv[0] + xv[1] * xv[1]) + (xv[2] * xv[2] + xv[3] * xv[3]);
                    }
                ss += __shfl_xor(ss, 16); ss += __shfl_xor(ss, 32);
                if (fq == 0) rss[(size_t)row * 16 + 4 * u.pn + wc] = ss;
                asm volatile("" ::: "memory");
            }
    }
};
struct EpiUp {
    static constexpr bool PERM = true, AFTER_DRAIN = false;
    bf16_t* O; int ldc; const float* rss;
    __device__ __forceinline__ void operator()(const f32x4 (&acc)[2][2][4][2], const Unit& u, int wr, int wc, int fr, int fq) const {
        const int row0 = u.pm * BM + wr * 64 + fr, col0 = u.pn * BM + wc * 32 + 8 * fq;
#pragma unroll
        for (int ai = 0; ai < 2; ++ai)
#pragma unroll
            for (int m = 0; m < 4; ++m) {
                const int row = row0 + ai * HALF + m * 16;
                const float rstd = row_rstd(rss, row);
                bf16_t* rowp = O + (size_t)row * ldc + col0;
#pragma unroll
                for (int bj = 0; bj < 2; ++bj) {
                    f32x4 v0 = acc[ai][bj][m][0] * rstd, v1 = acc[ai][bj][m][1] * rstd;
#pragma unroll
                    for (int e = 0; e < 4; ++e) { const float a = v0[e] > 0.f ? v0[e] : 0.f, b = v1[e] > 0.f ? v1[e] : 0.f; v0[e] = a * a; v1[e] = b * b; }
                    u32x4 w; w.x = cvt_pk_bf16(v0[0], v0[1]); w.y = cvt_pk_bf16(v0[2], v0[3]); w.z = cvt_pk_bf16(v1[0], v1[1]); w.w = cvt_pk_bf16(v1[2], v1[3]);
                    *(u32x4*)(rowp + bj * HALF) = w;
                }
            }
    }
};

template <class Epi, class Sched, bool ALIGN_EPI = false, bool SP2 = false>
__device__ __forceinline__ void gemm_phase(PG8_LAS unsigned char* lds, const Gemm g, const Sched& S, const Epi& E) {
    int tid_ = threadIdx.x; asm volatile("" : "+v"(tid_));
    const int tid = tid_, wid = __builtin_amdgcn_readfirstlane(tid >> 6), lane = tid & 63, wr = wid >> 2, wc = wid & 3, fr = lane & 15, fq = lane >> 4;
    const int K = g.K, nt = K / BK;
    unsigned voffA[2], voffB[2];
#pragma unroll
    for (int i = 0; i < 2; ++i) { int R, C; stage_rc(tid * 16 + i * 8192, R, C); const int Rb = Epi::PERM ? ((R & ~31) + perm32(R & 31)) : R;
        voffA[i] = (unsigned)(R * K + C) * 2u; voffB[i] = (unsigned)(Rb * K + C) * 2u; }
    const size_t kstep = (size_t)(BK * 2);
    const size_t hstep = (size_t)HALF * K * 2;
    const size_t tstep = 2 * hstep;
    const unsigned ldsw = (unsigned)wid * 1024u;
    const int aoff = lds_byte(wr * 64 + fr, fq * 8), boff = lds_byte(wc * 32 + fr, fq * 8);
#define PG8_SA(b, h) (((b) * 2 + (h)) * HTB)
#define PG8_SB(b, h) ((4 + (b) * 2 + (h)) * HTB)
#define PG8_STAGE(bufoff, gbase, voff) do { _Pragma("unroll") for (int _i = 0; _i < 2; ++_i) \
        __builtin_amdgcn_global_load_lds((const unsigned*)((const char*)(gbase) + (voff)[_i]), (PG8_LAS unsigned*)(lds + (bufoff) + ldsw + _i * 8192), 16, 0, 0); } while (0)
#define PG8_LDA(dst, b, h) do { _Pragma("unroll") for (int m = 0; m < 4; ++m) _Pragma("unroll") for (int k = 0; k < 2; ++k) dst[m][k] = *(const PG8_LAS bf16x8*)(lds + PG8_SA(b, h) + aoff + m * 2048 + k * 1024); } while (0)
#define PG8_LDB(dst, b, h) do { _Pragma("unroll") for (int n = 0; n < 2; ++n) _Pragma("unroll") for (int k = 0; k < 2; ++k) dst[n][k] = *(const PG8_LAS bf16x8*)(lds + PG8_SB(b, h) + boff + n * 2048 + k * 1024); } while (0)
#define PG8_MMA(ai, bj, At, Bt) do { __builtin_amdgcn_s_setprio(1); _Pragma("unroll") for (int m = 0; m < 4; ++m) _Pragma("unroll") for (int n = 0; n < 2; ++n) _Pragma("unroll") for (int k = 0; k < 2; ++k) \
        acc[ai][bj][m][n] = __builtin_amdgcn_mfma_f32_16x16x32_bf16(Bt[n][k], At[m][k], acc[ai][bj][m][n], 0, 0, 0); __builtin_amdgcn_s_setprio(0); } while (0)
#define PG8_WAIT_V(n) asm volatile("s_waitcnt vmcnt(" #n ")" ::: "memory")
#define PG8_WAIT_L(n) asm volatile("s_waitcnt lgkmcnt(" #n ")" ::: "memory")
#define PG8_BAR __builtin_amdgcn_s_barrier()
#define PG8_SCHED __builtin_amdgcn_sched_barrier(0)
    Unit cur, nxt; int ui = 0;
    if (!S.next(0, cur)) return;
    f32x4 acc[2][2][4][2];
#pragma unroll
    for (int a = 0; a < 2; ++a)
#pragma unroll
        for (int b = 0; b < 2; ++b)
#pragma unroll
            for (int m = 0; m < 4; ++m)
#pragma unroll
                for (int n = 0; n < 2; ++n) acc[a][b][m][n] = (f32x4){0.f, 0.f, 0.f, 0.f};
    bf16x8 At[4][2], B0[2][2], B1[2][2];
    const char* cA = (const char*)g.A + (size_t)cur.pm * tstep; const char* cB = (const char*)g.Bt + (size_t)cur.pn * tstep;
    S.a_ready(cur);
    if constexpr (SP2) {
        PG8_STAGE(PG8_SB(0, 0), cB, voffB); PG8_STAGE(PG8_SB(0, 1), cB + hstep, voffB); PG8_STAGE(PG8_SA(0, 0), cA, voffA); PG8_STAGE(PG8_SA(0, 1), cA + hstep, voffA);
        if (wr == 1) PG8_BAR;
        PG8_WAIT_V(2); PG8_BAR;
        PG8_STAGE(PG8_SB(1, 0), cB + kstep, voffB); PG8_STAGE(PG8_SA(1, 0), cA + kstep, voffA); PG8_STAGE(PG8_SB(1, 1), cB + hstep + kstep, voffB);
        PG8_WAIT_V(6); PG8_BAR;
    } else {
        PG8_STAGE(PG8_SB(0, 0), cB, voffB); PG8_STAGE(PG8_SA(0, 0), cA, voffA); PG8_STAGE(PG8_SB(0, 1), cB + hstep, voffB); PG8_STAGE(PG8_SA(0, 1), cA + hstep, voffA);
        if (wr == 1) PG8_BAR;
        PG8_WAIT_V(4); PG8_BAR;
        PG8_STAGE(PG8_SB(1, 0), cB + kstep, voffB); PG8_STAGE(PG8_SA(1, 0), cA + kstep, voffA); PG8_STAGE(PG8_SB(1, 1), cB + hstep + kstep, voffB);
        PG8_WAIT_V(6); PG8_BAR;
    }
    for (;;) {
        const bool has_next = S.next(ui + 1, nxt);
        const char* nA = has_next ? (const char*)g.A + (size_t)nxt.pm * tstep : cA; const char* nB = has_next ? (const char*)g.Bt + (size_t)nxt.pn * tstep : cB;
        for (int t = 0; t < nt; t += 2) {
            const bool last = (t == nt - 2);
            const char* a1 = cA + (size_t)(t + 1) * kstep;
            const char* a2 = last ? nA : cA + (size_t)(t + 2) * kstep; const char* b2 = last ? nB : cB + (size_t)(t + 2) * kstep;
            const char* a3 = a2 + kstep; const char* b3 = b2 + kstep;
            if (last && has_next) S.a_ready(nxt);
            if constexpr (SP2) {
            PG8_LDB(B0, 0, 0); PG8_LDB(B1, 0, 1); PG8_SCHED; PG8_LDA(At, 0, 0); PG8_STAGE(PG8_SA(1, 1), a1 + hstep, voffA);
            PG8_WAIT_V(8); PG8_WAIT_L(0); PG8_BAR; PG8_MMA(0, 0, At, B0); PG8_MMA(0, 1, At, B1); PG8_BAR; PG8_SCHED;
            PG8_LDA(At, 0, 1); PG8_STAGE(PG8_SB(0, 0), b2, voffB); PG8_STAGE(PG8_SB(0, 1), b2 + hstep, voffB); PG8_STAGE(PG8_SA(0, 0), a2, voffA);
            PG8_WAIT_V(8); PG8_WAIT_L(0); PG8_BAR; PG8_MMA(1, 0, At, B0); PG8_MMA(1, 1, At, B1); PG8_BAR; PG8_SCHED;
            PG8_LDB(B0, 1, 0); PG8_LDB(B1, 1, 1); PG8_SCHED; PG8_LDA(At, 1, 0); PG8_STAGE(PG8_SA(0, 1), a2 + hstep, voffA);
            PG8_WAIT_V(8); PG8_WAIT_L(0); PG8_BAR; PG8_MMA(0, 0, At, B0); PG8_MMA(0, 1, At, B1); PG8_BAR; PG8_SCHED;
            PG8_LDA(At, 1, 1); PG8_STAGE(PG8_SB(1, 0), b3, voffB); PG8_STAGE(PG8_SB(1, 1), b3 + hstep, voffB); PG8_STAGE(PG8_SA(1, 0), a3, voffA);
            PG8_WAIT_V(8); PG8_WAIT_L(0); PG8_BAR; PG8_MMA(1, 0, At, B0); PG8_MMA(1, 1, At, B1); PG8_BAR; PG8_SCHED;
            } else {
            PG8_LDB(B0, 0, 0); PG8_SCHED; PG8_LDA(At, 0, 0); PG8_STAGE(PG8_SA(1, 1), a1 + hstep, voffA);
            PG8_WAIT_L(8); PG8_BAR; PG8_WAIT_L(0); PG8_MMA(0, 0, At, B0); PG8_BAR; PG8_SCHED;
            PG8_LDB(B1, 0, 1); PG8_STAGE(PG8_SB(0, 0), b2, voffB);
            PG8_BAR; PG8_WAIT_L(0); PG8_MMA(0, 1, At, B1); PG8_BAR;
            PG8_LDA(At, 0, 1); PG8_STAGE(PG8_SA(0, 0), a2, voffA);
            PG8_BAR; PG8_WAIT_L(0); PG8_MMA(1, 0, At, B0); PG8_BAR; PG8_SCHED;
            PG8_STAGE(PG8_SB(0, 1), b2 + hstep, voffB);
            PG8_WAIT_V(6); PG8_BAR; PG8_MMA(1, 1, At, B1); PG8_BAR;
            PG8_LDB(B0, 1, 0); PG8_SCHED; PG8_LDA(At, 1, 0); PG8_STAGE(PG8_SA(0, 1), a2 + hstep, voffA);
            PG8_WAIT_L(8); PG8_BAR; PG8_WAIT_L(0); PG8_MMA(0, 0, At, B0); PG8_BAR; PG8_SCHED;
            PG8_LDB(B1, 1, 1); PG8_STAGE(PG8_SB(1, 0), b3, voffB);
            PG8_BAR; PG8_WAIT_L(0); PG8_MMA(0, 1, At, B1); PG8_BAR;
            PG8_LDA(At, 1, 1); PG8_STAGE(PG8_SA(1, 0), a3, voffA);
            PG8_BAR; PG8_WAIT_L(0); PG8_MMA(1, 0, At, B0); PG8_BAR; PG8_SCHED;
            PG8_STAGE(PG8_SB(1, 1), b3 + hstep, voffB);
            PG8_WAIT_V(6); PG8_BAR; PG8_MMA(1, 1, At, B1); PG8_BAR;
            }
        }
        if constexpr (ALIGN_EPI) { if (wr == 0) PG8_BAR; }
        if constexpr (!Epi::AFTER_DRAIN) { E(acc, cur, wr, wc, fr, fq); S.done(cur); }
        if (!has_next) break;
#pragma unroll
        for (int a = 0; a < 2; ++a)
#pragma unroll
            for (int b = 0; b < 2; ++b)
#pragma unroll
                for (int m = 0; m < 4; ++m)
#pragma unroll
                    for (int n = 0; n < 2; ++n) acc[a][b][m][n] = (f32x4){0.f, 0.f, 0.f, 0.f};
        cur = nxt; cA = nA; cB = nB; ++ui;
        if constexpr (ALIGN_EPI) { if (wr == 1) PG8_BAR; }
    }
    PG8_WAIT_V(0);
    if constexpr (!ALIGN_EPI) { if (wr == 0) PG8_BAR; }
    PG8_BAR;
    if constexpr (Epi::AFTER_DRAIN) { E.fused(acc, cur, wr, wc, fr, fq, lds, wid, lane); S.done(cur); }
#undef PG8_SA
#undef PG8_SB
#undef PG8_STAGE
#undef PG8_LDA
#undef PG8_LDB
#undef PG8_MMA
#undef PG8_WAIT_V
#undef PG8_WAIT_L
#undef PG8_BAR
#undef PG8_SCHED
}
}
#define GAS __attribute__((address_space(1)))
#define LAS __attribute__((address_space(3)))
typedef unsigned short bf16;
typedef unsigned v4u __attribute__((ext_vector_type(4)));
typedef float f32x4 __attribute__((ext_vector_type(4)));
typedef short bf16x8 __attribute__((ext_vector_type(8)));
typedef GAS unsigned gu32;
typedef GAS unsigned long long gu64;
#define RLX_AGENT __ATOMIC_RELAXED, __HIP_MEMORY_SCOPE_AGENT
#define LDS_WAIT() asm volatile("s_waitcnt lgkmcnt(0)" ::: "memory")
#define VM_WAIT() asm volatile("s_waitcnt vmcnt(0)" ::: "memory")
__device__ __forceinline__ unsigned long long rt() { return __builtin_amdgcn_s_memrealtime(); }
__device__ __forceinline__ unsigned f2bf(float f) { unsigned u = __builtin_bit_cast(unsigned, f); return (u + 0x7fffu + ((u >> 16) & 1u)) >> 16; }
__device__ __forceinline__ unsigned pk2(float lo, float hi) { return f2bf(lo) | (f2bf(hi) << 16); }

#define XB_TMO      128
#define XB_XCNT(j)  (256  + 64 * (j))
#define XB_XSUB(j)  (1280 + 64 * (j))
#define XB_XGEN(j)  (2304 + 64 * (j))
#define XB_TOP      3328
#define XB_TOPGEN   3392
#define XCD_BAR_WORDS 3456
#define XB_SPIN_CAP (1u << 18)

__device__ __forceinline__ unsigned xb_ld(unsigned* p)              { return __hip_atomic_load(p, __ATOMIC_RELAXED, __HIP_MEMORY_SCOPE_AGENT); }
__device__ __forceinline__ unsigned xb_add(unsigned* p, unsigned v) { return __hip_atomic_fetch_add(p, v, __ATOMIC_RELAXED, __HIP_MEMORY_SCOPE_AGENT); }
__device__ __forceinline__ unsigned xb_xcc_id() { return (unsigned)__builtin_amdgcn_s_getreg((3 << 11) | 20) & 0xFu; }
#define XB_SPIN(cond, bar) do { unsigned _sp = 0; while (cond) { __builtin_amdgcn_s_sleep(1); \
    if ((++_sp & 255u) == 0u) { if (xb_ld(&(bar)[XB_TMO])) break; if (_sp > XB_SPIN_CAP) { atomicAdd(&(bar)[XB_TMO], 1u); break; } } } } while (0)

struct XcdBarrier {
    unsigned* bar; unsigned x;
    volatile LAS unsigned* st;
};

__device__ __forceinline__ XcdBarrier xcd_barrier_post(unsigned* bar, volatile LAS unsigned* st) {
    XcdBarrier b; b.bar = bar; b.x = xb_xcc_id(); b.st = st;
    if (threadIdx.x == 0) (void)xb_add(&bar[XB_XCNT(b.x)], 1u);
    return b;
}
__device__ __forceinline__ void xcd_barrier_complete(unsigned* bar, unsigned x, unsigned& nloc, unsigned& nx) {
    const unsigned G = gridDim.x * gridDim.y * gridDim.z;
    unsigned sum, cnt, mine, sp = 0u;
    for (;;) {
        sum = 0u; cnt = 0u; mine = 0u;
#pragma unroll
        for (unsigned j = 0; j < 16; ++j) { const unsigned c = xb_ld(&bar[XB_XCNT(j)]); sum += c; cnt += (c > 0u) ? 1u : 0u; mine = (j == x) ? c : mine; }
        if (sum == G) break;
        __builtin_amdgcn_s_sleep(1);
        if ((++sp & 255u) == 0u) { if (xb_ld(&bar[XB_TMO])) break; if (sp > XB_SPIN_CAP) { atomicAdd(&bar[XB_TMO], 1u); break; } }
    }
    nloc = mine > 0u ? mine : 1u; nx = cnt > 0u ? cnt : 1u;
}

__device__ __forceinline__ void xcd_barrier(const XcdBarrier& b) {
    asm volatile("s_waitcnt vmcnt(0)" ::: "memory");
    __syncthreads();
    if (threadIdx.x == 0) {
        unsigned* bar = b.bar;
        __builtin_amdgcn_s_waitcnt(0);
        unsigned nloc = b.st[0], nx = b.st[1];
        if (nloc == 0u) { xcd_barrier_complete(bar, b.x, nloc, nx); b.st[0] = nloc; b.st[1] = nx; }
        const unsigned old = xb_add(&bar[XB_XSUB(b.x)], 1u);
        const unsigned gen = old / nloc;
        if (old + 1u == (gen + 1u) * nloc) {
            __builtin_amdgcn_fence(__ATOMIC_RELEASE, "agent");
            asm volatile("s_waitcnt vmcnt(0)" ::: "memory");
            const unsigned og = xb_add(&bar[XB_TOP], 1u);
            const unsigned tg = og / nx;
            if (og + 1u == (tg + 1u) * nx) xb_add(&bar[XB_TOPGEN], 1u);
            else XB_SPIN(xb_ld(&bar[XB_TOPGEN]) == tg, bar);
            __builtin_amdgcn_fence(__ATOMIC_ACQUIRE, "agent");
            xb_add(&bar[XB_XGEN(b.x)], 1u);
            asm volatile("s_waitcnt vmcnt(0)" ::: "memory");
        } else {
            XB_SPIN(xb_ld(&bar[XB_XGEN(b.x)]) == gen, bar);
            __builtin_amdgcn_fence(__ATOMIC_ACQUIRE, "agent");
            asm volatile("s_waitcnt vmcnt(0)" ::: "memory");
        }
    }
    __syncthreads();
}

namespace att {
typedef short bf16x8 __attribute__((ext_vector_type(8)));
typedef short s16x4 __attribute__((ext_vector_type(4)));
typedef short v4i16_t __attribute__((ext_vector_type(4)));
typedef float f32x16 __attribute__((ext_vector_type(16)));
typedef unsigned u32x4 __attribute__((ext_vector_type(4)));
typedef unsigned u32x2 __attribute__((ext_vector_type(2)));
typedef float f32x2_t __attribute__((ext_vector_type(2))); typedef __bf16 bf16x2_t __attribute__((ext_vector_type(2)));
typedef unsigned short bf16_t;
#define ALAS __attribute__((address_space(3)))
constexpr float LOG2E = 1.4426950408889634f;
__device__ __forceinline__ int crow(int r, int hi) { return (r & 3) + 8 * (r >> 2) + 4 * hi; }
__device__ __forceinline__ unsigned cvtpk(float lo, float hi) { f32x2_t v = {lo, hi}; bf16x2_t b = __builtin_convertvector(v, bf16x2_t); return __builtin_bit_cast(unsigned, b); }
__device__ __forceinline__ s16x4 vtr(const ALAS unsigned char* p) { return __builtin_bit_cast(s16x4, __builtin_amdgcn_ds_read_tr16_b64_v4i16((ALAS v4i16_t*)p)); }
__device__ __forceinline__ int clampi(int v, int lo, int hi) { return v < lo ? lo : (v > hi ? hi : v); }

struct AttnP { const bf16_t* Q; const bf16_t* K; const bf16_t* V; int pitch; bf16_t* O; float* lse; const float* rpb; int dlog; int g; };

constexpr int WAVE_LDS = 8192;

template <int MODE>
__device__ __forceinline__ void attn_unit(const AttnP& P, int u, ALAS unsigned char* wl, int lane_) {
    int lane = lane_; asm volatile("" : "+v"(lane));
    const int q = lane & 31, hi = lane >> 5;
    int b, h, hk, qtok, tok0, tstep, kstr, nt, jt0;
    int rq = 0, cq = 0, kstart = 0;
    if (MODE == 0) {
        const int dlog = P.dlog, d = 1 << dlog, nblk = 64 >> dlog;
        h = u & 15; int rest = u >> 4; const int blk = rest & (nblk - 1); rest >>= (6 - dlog); const int r = rest & (d - 1); b = rest >> dlog; hk = h;
        const int i0 = 32 * blk, L = 2048 >> dlog;
        qtok = b * 2048 + ((i0 + q) << dlog) + r;
        const int jlo = (i0 < 64) ? ((64 - i0) >> 5) : 0; int jhi = (L - i0 + 64) >> 5; if (jhi > 5) jhi = 5;
        jt0 = jlo; nt = jhi - jlo;
        tok0 = b * 2048 + ((i0 - 64 + 32 * jlo) << dlog) + r; tstep = 32 << dlog; kstr = d;
    } else if (MODE == 1) {
        h = u & 15; const int rest = u >> 4; const int cb = rest & 3, rp = (rest >> 2) & 15; b = rest >> 6; hk = h;
        rq = 2 * rp + (q >> 4); cq = 16 * cb + (q & 15);
        qtok = b * 2048 + rq * 64 + cq;
        kstart = clampi(16 * cb - 8, 0, 32);
        const int rs0 = clampi(2 * rp - 4, 0, 24), rs1 = clampi(2 * rp - 3, 0, 24);
        jt0 = rs0; nt = rs1 + 8 - rs0;
        tok0 = b * 2048 + rs0 * 64 + kstart; tstep = 64; kstr = 1;
    } else {
        const int qblk = u & 63; h = (u >> 6) & 15; b = u >> 10; hk = h >> 2;
        qtok = b * 2048 + 32 * qblk + q; jt0 = 0; nt = 64; tok0 = b * 2048; tstep = 32; kstr = 1;
    }
    const int pitch = P.pitch;
    ALAS float* tab = (ALAS float*)(wl + 4096);
    if (MODE == 1) {
#pragma unroll
        for (int k = 0; k < 8; ++k) { const int i = lane + 64 * k; if (i < 465) tab[i] = P.rpb[h * 465 + i] * LOG2E; }
    }
    bf16x8 qf[4];
    { const bf16_t* qp = P.Q + (size_t)qtok * pitch + h * 64 + hi * 8;
#pragma unroll
      for (int ks = 0; ks < 4; ++ks) qf[ks] = *(const bf16x8*)(qp + 16 * ks); }
    const bf16_t* kp = P.K + hk * 64 + hi * 8 + (size_t)(tok0 + q * kstr) * pitch;
    const bf16_t* vp = P.V + hk * 64 + (lane & 7) * 8 + (size_t)(tok0 + (lane >> 3) * kstr) * pitch;
    const size_t tstepb = (size_t)tstep * pitch, vpiece = (size_t)8 * kstr * pitch;
    const int vwoff = ((lane & 7) >> 2) * 2048 + (lane >> 3) * 64 + (lane & 3) * 16;
    const ALAS unsigned char* vb = wl + (4 * hi + ((lane & 15) >> 2)) * 64 + ((lane >> 4) & 1) * 32 + (lane & 3) * 8;
    bf16x8 kn[4], vn[4];
#pragma unroll
    for (int ks = 0; ks < 4; ++ks) kn[ks] = *(const bf16x8*)(kp + 16 * ks);
#pragma unroll
    for (int i = 0; i < 4; ++i) vn[i] = *(const bf16x8*)(vp + i * vpiece);
    f32x16 o0 = {}, o1 = {};
    float mrun = -1e30f, l = 0.f;
    for (int t = 0; t < nt; ++t) {
        bf16x8 kc[4], vc[4];
#pragma unroll
        for (int i = 0; i < 4; ++i) { kc[i] = kn[i]; vc[i] = vn[i]; }
        if (t + 1 < nt) {
            kp += tstepb; vp += tstepb;
#pragma unroll
            for (int ks = 0; ks < 4; ++ks) kn[ks] = *(const bf16x8*)(kp + 16 * ks);
#pragma unroll
            for (int i = 0; i < 4; ++i) vn[i] = *(const bf16x8*)(vp + i * vpiece);
        }
#pragma unroll
        for (int i = 0; i < 4; ++i) *(ALAS bf16x8*)(wl + vwoff + i * 512) = vc[i];
        f32x16 p = {};
#pragma unroll
        for (int ks = 0; ks < 4; ++ks) p = __builtin_amdgcn_mfma_f32_32x32x16_bf16(kc[ks], qf[ks], p, 0, 0, 0);
        const float NEG = -__builtin_inff();
        if (MODE == 0) {
            const int jt = jt0 + t;
            if (jt == 0) {
#pragma unroll
                for (int r = 0; r < 16; ++r) if (crow(r, hi) < q) p[r] = NEG;
            }
            if (jt == 4) {
#pragma unroll
                for (int r = 0; r < 16; ++r) if (crow(r, hi) > q) p[r] = NEG;
            }
        } else if (MODE == 1) {
            const int kr = jt0 + t, rsq = clampi(rq - 4, 0, 24), csq = clampi(cq - 8, 0, 48);
            const bool row_ok = (kr >= rsq) && (kr < rsq + 8);
            const int bidx = (kr - rq + 7) * 31 + (kstart - cq + 15);
#pragma unroll
            for (int r = 0; r < 16; ++r) {
                const int kc_ = kstart + crow(r, hi);
                const bool ok = row_ok && (kc_ >= csq) && (kc_ < csq + 16);
                const float bias = tab[ok ? bidx + crow(r, hi) : 0];
                p[r] = ok ? p[r] + bias : NEG;
            }
        }
        float mx = p[0];
#pragma unroll
        for (int r = 1; r < 16; ++r) mx = fmaxf(mx, p[r]);
        mx = fmaxf(mx, __shfl_xor(mx, 32));
        const float mn = fmaxf(mrun, mx);
        const float alpha = __builtin_amdgcn_exp2f(mrun - mn);
        mrun = mn;
        float rs = 0.f;
#pragma unroll
        for (int r = 0; r < 16; ++r) { p[r] = __builtin_amdgcn_exp2f(p[r] - mn); rs += p[r]; }
        l = l * alpha + rs;
#pragma unroll
        for (int r = 0; r < 16; ++r) { o0[r] *= alpha; o1[r] *= alpha; }
        u32x4 w0, w1;
        w0.x = cvtpk(p[0], p[1]); w0.y = cvtpk(p[2], p[3]); w0.z = cvtpk(p[4], p[5]); w0.w = cvtpk(p[6], p[7]);
        w1.x = cvtpk(p[8], p[9]); w1.y = cvtpk(p[10], p[11]); w1.z = cvtpk(p[12], p[13]); w1.w = cvtpk(p[14], p[15]);
        const bf16x8 pf0 = __builtin_bit_cast(bf16x8, w0), pf1 = __builtin_bit_cast(bf16x8, w1);
#define ATT_VF(off) ({ const s16x4 lo_ = vtr(vb + (off)), hi_ = vtr(vb + (off) + 512); (bf16x8){lo_[0], lo_[1], lo_[2], lo_[3], hi_[0], hi_[1], hi_[2], hi_[3]}; })
        { const bf16x8 v00 = ATT_VF(0), v01 = ATT_VF(1024), v10 = ATT_VF(2048), v11 = ATT_VF(2048 + 1024);
          o0 = __builtin_amdgcn_mfma_f32_32x32x16_bf16(v00, pf0, o0, 0, 0, 0);
          o1 = __builtin_amdgcn_mfma_f32_32x32x16_bf16(v10, pf0, o1, 0, 0, 0);
          o0 = __builtin_amdgcn_mfma_f32_32x32x16_bf16(v01, pf1, o0, 0, 0, 0);
          o1 = __builtin_amdgcn_mfma_f32_32x32x16_bf16(v11, pf1, o1, 0, 0, 0); }
#undef ATT_VF
    }
    l += __shfl_xor(l, 32);
    const float inv = 1.0f / l;
    float wc_ = inv, wp_ = 0.f;
    if (MODE == 0) {
        float lse_new = mrun + __builtin_amdgcn_logf(l);
        if (P.g > 0) {
            const float lp = P.lse[(size_t)qtok * 16 + h];
            const float mm = fmaxf(lp, lse_new), ep = __builtin_amdgcn_exp2f(lp - mm), ec = __builtin_amdgcn_exp2f(lse_new - mm), den = ep + ec;
            wp_ = ep / den; wc_ = inv * (ec / den); lse_new = mm + __builtin_amdgcn_logf(den);
        }
        if (P.g < 2 && hi == 0) P.lse[(size_t)qtok * 16 + h] = lse_new;
    }
    bf16_t* op = P.O + (size_t)qtok * 1024 + h * 64 + 4 * hi;
#pragma unroll
    for (int db = 0; db < 2; ++db)
#pragma unroll
        for (int rr = 0; rr < 4; ++rr) {
            float v[4];
#pragma unroll
            for (int e = 0; e < 4; ++e) v[e] = (db == 0 ? o0[4 * rr + e] : o1[4 * rr + e]) * wc_;
            u32x2* dst = (u32x2*)(op + 32 * db + 8 * rr);
            if (MODE == 0 && P.g > 0) {
                const u32x2 pv = *dst;
                v[0] += wp_ * __uint_as_float(pv.x << 16); v[1] += wp_ * __uint_as_float(pv.x & 0xffff0000u);
                v[2] += wp_ * __uint_as_float(pv.y << 16); v[3] += wp_ * __uint_as_float(pv.y & 0xffff0000u);
            }
            u32x2 w; w.x = cvtpk(v[0], v[1]); w.y = cvtpk(v[2], v[3]);
            *dst = w;
        }
}
template <int MODE>
__device__ __forceinline__ void attn_phase(const AttnP& P, ALAS unsigned char* lds, int vcu, int wave, int lane) {
    ALAS unsigned char* wl = lds + wave * WAVE_LDS;
    for (int k = 0; k < 4; ++k) {
        int u;
        if (MODE == 2) { const int grp = vcu >> 3, j = vcu & 7, b = grp >> 2, kvh = grp & 3, h = kvh * 4 + (j >> 1), qblk = (j & 1) * 32 + k * 8 + wave; u = ((b * 16 + h) << 6) | qblk; }
        else u = vcu * 32 + k * 8 + wave;
        attn_unit<MODE>(P, u, wl, lane);
    }
}
}

constexpr int NWAVES = 8;
#ifndef MK_N_LAUNCHES
#define MK_N_LAUNCHES 30
#endif
constexpr int N_PHASES = 30;
constexpr int N_LAUNCHES = MK_N_LAUNCHES;
constexpr int BATCH = 8, SEQ = 2048, D = 1024, FF = 4096, M = BATCH * SEQ;
constexpr size_t MiB = 1u << 20;
constexpr size_t WS_CTL = 0, CTL_ZERO_BYTES = 1 * MiB;
constexpr size_t WS_TAB = 1 * MiB;
constexpr size_t WS_RSS = 2 * MiB;
constexpr size_t WS_LSE = 3 * MiB;
constexpr size_t WS_XB = 121 * MiB;
constexpr size_t WS_ACT = 153 * MiB, WS_QKV = WS_ACT, WS_O = 249 * MiB, WS_H = WS_ACT, WS_END = 281 * MiB;
constexpr int CW_BAR = 4096;
constexpr int RING_OFF = 0, RING_BYTES = 131072;
constexpr int LDSCTL_OFF = RING_BYTES, MISC_OFF = LDSCTL_OFF + 320;
constexpr int LDS_BYTES = 147456;

struct Args { const float* in[29]; float* out; unsigned char* ws; int ph_lo, ph_hi; };
struct LayerDesc { const float *anorm, *win, *wout, *mnorm, *wup, *wdown, *rpb, *qn, *kn; int kind, nin; size_t o_in, o_out, o_up, o_down; };
__device__ __forceinline__ LayerDesc get_layer(const Args& a, int L) {
    LayerDesc d; int base, wo;
    if (L == 0)      { base = 1;  wo = 3;  d.kind = 0; d.nin = 9216; d.o_in = 4 * MiB;  d.o_out = 22 * MiB;  d.o_up = 24 * MiB;  d.o_down = 32 * MiB; }
    else if (L == 1) { base = 7;  wo = 10; d.kind = 1; d.nin = 3072; d.o_in = 40 * MiB; d.o_out = 46 * MiB;  d.o_up = 48 * MiB;  d.o_down = 56 * MiB; }
    else if (L == 2) { base = 14; wo = 18; d.kind = 2; d.nin = 1536; d.o_in = 64 * MiB; d.o_out = 67 * MiB;  d.o_up = 69 * MiB;  d.o_down = 77 * MiB; }
    else             { base = 22; wo = 24; d.kind = 0; d.nin = 9216; d.o_in = 85 * MiB; d.o_out = 103 * MiB; d.o_up = 105 * MiB; d.o_down = 113 * MiB; }
    d.anorm = a.in[base]; d.win = a.in[base + 1]; d.wout = a.in[wo]; d.mnorm = a.in[wo + 1]; d.wup = a.in[wo + 2]; d.wdown = a.in[wo + 3];
    d.rpb = a.in[9]; d.qn = a.in[16]; d.kn = a.in[17];
    return d;
}

__device__ __forceinline__ float wave_sum(float v) {
#pragma unroll
    for (int o = 1; o < 64; o <<= 1) v += __shfl_xor(v, o);
    return v;
}
__device__ __forceinline__ void transpose_item(const float* W, int K, int N, bf16* WT, const float* gain, bool perm, LAS float* scr, int item, int lane) {
    const int nblk = N / 32, kb = item / nblk, nb = item - kb * nblk, k0 = 64 * kb, n0 = 32 * nb;
#pragma unroll
    for (int i = 0; i < 8; ++i) { const int kk = 8 * i + (lane >> 3), n4 = 4 * (lane & 7);
        f32x4 v = *(const GAS f32x4*)(W + (size_t)(k0 + kk) * N + n0 + n4); const float gk = gain ? gain[k0 + kk] : 1.0f;
        LAS float* s = scr + kk * 33 + n4; s[0] = v[0] * gk; s[1] = v[1] * gk; s[2] = v[2] * gk; s[3] = v[3] * gk; }
    LDS_WAIT(); asm volatile("" ::: "memory");
    const int c = lane & 7;
    const int nrow0 = perm ? ((n0 & ~255) | (((n0 >> 5) & 1) << 7) | (((n0 >> 6) & 3) << 5)) : n0;
#pragma unroll
    for (int j = 0; j < 4; ++j) { const int n = (lane >> 3) + 8 * j; const LAS float* s = scr + (8 * c) * 33 + n;
        v4u o; o.x = pk2(s[0 * 33], s[1 * 33]); o.y = pk2(s[2 * 33], s[3 * 33]); o.z = pk2(s[4 * 33], s[5 * 33]); o.w = pk2(s[6 * 33], s[7 * 33]);
        *(GAS v4u*)(WT + (size_t)(nrow0 + n) * K + k0 + 8 * c) = o; }
    LDS_WAIT(); asm volatile("" ::: "memory");
}
__device__ __forceinline__ void sincos_d(double a, float& s, float& c) {
    const double k = __builtin_rint(a * 0.63661977236758134308);
    const double r = __builtin_fma(-k, 1.57079632679489655800e+00, a) - k * 6.12323399573676603587e-17;
    const double z = r * r;
    double sp = -1.0 / 1307674368000.0; sp = sp * z + 1.0 / 6227020800.0; sp = sp * z - 1.0 / 39916800.0; sp = sp * z + 1.0 / 362880.0; sp = sp * z - 1.0 / 5040.0; sp = sp * z + 1.0 / 120.0; sp = sp * z - 1.0 / 6.0; sp = sp * z * r + r;
    double cp = 1.0 / 20922789888000.0; cp = cp * z - 1.0 / 87178291200.0; cp = cp * z + 1.0 / 479001600.0; cp = cp * z - 1.0 / 3628800.0; cp = cp * z + 1.0 / 40320.0; cp = cp * z - 1.0 / 720.0; cp = cp * z + 1.0 / 24.0; cp = cp * z - 0.5; cp = cp * z + 1.0;
    const int qd = ((int)k) & 3;
    const double ss = (qd == 0) ? sp : (qd == 1) ? cp : (qd == 2) ? -sp : -cp;
    const double cc = (qd == 0) ? cp : (qd == 1) ? -sp : (qd == 2) ? -cp : sp;
    s = (float)ss; c = (float)cc;
}

__global__ void __launch_bounds__(NWAVES * 64, 2) mk_fwd(Args args) {
    extern __shared__ __attribute__((aligned(16))) unsigned char lds[];
    LAS unsigned char* const L3 = (LAS unsigned char*)lds;
    volatile LAS unsigned* const MISC = (volatile LAS unsigned*)(L3 + MISC_OFF);
    const int tid = threadIdx.x, lane = tid & 63, wave = __builtin_amdgcn_readfirstlane(tid >> 6);
    const int G = gridDim.x; const int bx = blockIdx.x; const int vcu = (G % 8 == 0) ? (bx % 8) * (G / 8) + bx / 8 : bx;
    unsigned char* const ws = args.ws;
    gu32* const ctl = (gu32*)(ws + WS_CTL);
    for (int u = tid; u < (LDS_BYTES - LDSCTL_OFF) / 4; u += NWAVES * 64) ((LAS unsigned*)(L3 + LDSCTL_OFF))[u] = 0u;
    __syncthreads();
    XcdBarrier bar; bar.bar = (unsigned*)(ctl + CW_BAR); bar.x = 0; bar.st = nullptr;
    if (N_LAUNCHES == 1) bar = xcd_barrier_post((unsigned*)(ctl + CW_BAR), MISC + 8);
    const int lo = args.ph_lo, hi = args.ph_hi;
    int ph = 0;
#define PH_ON() (lo <= ph && ph < hi)
#define PH_END() do { if (ph + 1 < hi) { if (N_LAUNCHES == 1) xcd_barrier(bar); } ++ph; } while (0)

#define tabs ((float*)(ws + WS_TAB))
#define cosA (tabs)
#define sinA (tabs + 65536)
#define cosC (tabs + 131072)
#define sinC (tabs + 196608)
#define rss ((float*)(ws + WS_RSS))
#define lse ((float*)(ws + WS_LSE))
#define XB ((bf16*)(ws + WS_XB))
#define QKV ((bf16*)(ws + WS_QKV))
#define OB ((bf16*)(ws + WS_O))
#define HB ((bf16*)(ws + WS_H))
    const int gw = vcu * NWAVES + wave, NGW = G * NWAVES;

    if (PH_ON()) {
        LAS float* scr = (LAS float*)(L3 + RING_OFF + wave * 16384);
        int rot = 0;
        for (int mi = 0; mi < 16; ++mi) {
            const LayerDesc d = get_layer(args, mi >> 2); const int j = mi & 3;
            const float* W = j == 0 ? d.win : j == 1 ? d.wout : j == 2 ? d.wup : d.wdown;
            const int K = j == 3 ? FF : D, N = j == 0 ? d.nin : j == 2 ? FF : D;
            const float* gain = j == 0 ? d.anorm : j == 2 ? d.mnorm : nullptr;
            bf16* WT = (bf16*)(ws + (j == 0 ? d.o_in : j == 1 ? d.o_out : j == 2 ? d.o_up : d.o_down));
            const int nitems = (K / 64) * (N / 32);
            int it0 = (gw - rot) % NGW; if (it0 < 0) it0 += NGW;
            for (int it = it0; it < nitems; it += NGW) transpose_item(W, K, N, WT, gain, j == 0, scr, it, lane);
            rot = (rot + nitems) % NGW;
        }
        const float* x = args.in[0];
        for (int m = gw; m < M; m += NGW) {
            const GAS f32x4* xr = (const GAS f32x4*)(x + (size_t)m * D) + lane;
            f32x4 v[4]; float s = 0.f;
#pragma unroll
            for (int j = 0; j < 4; ++j) { v[j] = xr[64 * j]; s += (v[j].x * v[j].x + v[j].y * v[j].y) + (v[j].z * v[j].z + v[j].w * v[j].w); }
            s = wave_sum(s);
            GAS unsigned long long* o8 = (GAS unsigned long long*)(XB + (size_t)m * D) + lane;
#pragma unroll
            for (int j = 0; j < 4; ++j) o8[64 * j] = (unsigned long long)pk2(v[j].x, v[j].y) | ((unsigned long long)pk2(v[j].z, v[j].w) << 32);
            if (lane < 16) rss[(size_t)m * 16 + lane] = (lane == 0) ? s : 0.f;
        }
        for (int gid = bx * (NWAVES * 64) + tid; gid < 131072; gid += G * NWAVES * 64) {
            const int tb = gid >> 16, t = (gid >> 5) & 2047, i = gid & 31;
            float ang;
            if (tb == 0) { const float inv = 1.0f / powf(10000.0f, (float)(2 * i) / 64.0f); ang = (float)t * inv; }
            else { const int ii = i & 15; const float inv = 1.0f / powf(10000.0f, (float)(2 * ii) / 32.0f); const int pos = (i < 16) ? (t >> 6) : (t & 63); ang = (float)pos * inv; }
            float s, c; sincos_d((double)ang, s, c);
            if (tb == 0) { cosA[t * 32 + i] = c; sinA[t * 32 + i] = s; } else { cosC[t * 32 + i] = c; sinC[t * 32 + i] = s; }
        }
    }
    PH_END();

    for (int L = 0; L < 4; ++L) {
        const int kind = (L == 1) ? 1 : (L == 2) ? 2 : 0;
#define LD() const LayerDesc d = get_layer(args, L)
        if (kind == 0) {
            for (int g = 0; g < 3; ++g) {
                if (PH_ON()) {
                    LD(); pg8::Gemm gm{XB, (const bf16*)(ws + d.o_in) + (size_t)g * 3072 * D, M, 3072, D}; pg8::StaticOrder S; S.init(M, 3072, G, bx);
                    pg8::EpiQKV<0> E{QKV, 3072, rss, cosA, sinA, nullptr, nullptr};
                    pg8::gemm_phase<pg8::EpiQKV<0>, pg8::StaticOrder, true, true>(L3 + RING_OFF, gm, S, E);
                }
                PH_END();
                if (PH_ON()) {
                    att::AttnP P{QKV, QKV + 1024, QKV + 2048, 3072, OB, lse, nullptr, g == 0 ? 0 : (g == 1 ? 2 : 4), g};
                    att::attn_phase<0>(P, L3 + RING_OFF, vcu, wave, lane);
                }
                PH_END();
            }
        } else if (kind == 1) {
            if (PH_ON()) {
                LD(); pg8::Gemm gm{XB, (const bf16*)(ws + d.o_in), M, 3072, D}; pg8::StaticOrder S; S.init(M, 3072, G, bx);
                pg8::EpiQKV<1> E{QKV, 3072, rss, nullptr, nullptr, nullptr, nullptr};
                pg8::gemm_phase<pg8::EpiQKV<1>, pg8::StaticOrder, true, true>(L3 + RING_OFF, gm, S, E);
            }
            PH_END();
            if (PH_ON()) {
                att::AttnP P{QKV, QKV + 1024, QKV + 2048, 3072, OB, lse, args.in[9], 0, 0};
                att::attn_phase<1>(P, L3 + RING_OFF, vcu, wave, lane);
            }
            PH_END();
        } else {
            if (PH_ON()) {
                LD(); pg8::Gemm gm{XB, (const bf16*)(ws + d.o_in), M, 1536, D}; pg8::StaticOrder S; S.init(M, 1536, G, bx);
                pg8::EpiQKV<2> E{QKV, 1536, rss, cosC, sinC, args.in[16], args.in[17]};
                pg8::gemm_phase<pg8::EpiQKV<2>, pg8::StaticOrder, true, true>(L3 + RING_OFF, gm, S, E);
            }
            PH_END();
            if (PH_ON()) {
                att::AttnP P{QKV, QKV + 1024, QKV + 1280, 1536, OB, lse, nullptr, 0, 0};
                att::attn_phase<2>(P, L3 + RING_OFF, vcu, wave, lane);
            }
            PH_END();
        }
        if (PH_ON()) {
            LD(); pg8::Gemm gm{OB, (const bf16*)(ws + d.o_out), M, D, D}; pg8::StaticOrder S; S.init(M, D, G, bx);
            pg8::EpiRes E{L == 0 ? args.in[0] : args.out, args.out, XB, rss};
            pg8::gemm_phase<pg8::EpiRes, pg8::StaticOrder, false, true>(L3 + RING_OFF, gm, S, E);
        }
        PH_END();
        if (PH_ON()) {
            LD(); pg8::Gemm gm{XB, (const bf16*)(ws + d.o_up), M, FF, D}; pg8::StaticOrder S; S.init(M, FF, G, bx);
            pg8::EpiUp E{HB, FF, rss};
            pg8::gemm_phase<pg8::EpiUp, pg8::StaticOrder, true, true>(L3 + RING_OFF, gm, S, E);
        }
        PH_END();
        if (PH_ON()) {
            LD(); pg8::Gemm gm{HB, (const bf16*)(ws + d.o_down), M, D, FF}; pg8::StaticOrder S; S.init(M, D, G, bx);
            pg8::EpiRes E{args.out, args.out, XB, rss};
            pg8::gemm_phase<pg8::EpiRes, pg8::StaticOrder, false, true>(L3 + RING_OFF, gm, S, E);
        }
        PH_END();
    }
    if (PH_ON()) {
        const float* gf = args.in[28];
        for (int m = gw; m < M; m += NGW) {
            const float rstd = pg8::row_rstd(rss, m);
            GAS f32x4* xr = (GAS f32x4*)(args.out + (size_t)m * D) + lane; const GAS f32x4* gr = (const GAS f32x4*)gf + lane;
#pragma unroll
            for (int j = 0; j < 4; ++j) { const f32x4 v = xr[64 * j], gg = gr[64 * j]; xr[64 * j] = v * rstd * gg; }
        }
    }
#undef PH_ON
#undef PH_END
#undef LD
}

extern "C" void kernel_launch(void* const* d_in, const int* in_sizes, int n_in, void* d_out, int out_size, void* d_ws, size_t ws_size, hipStream_t stream) {
    static int grid = 0;
    if (grid == 0) {
        if (n_in != 29 || in_sizes[0] != M * D || out_size != M * D || ws_size < WS_END) { fprintf(stderr, "kernel_launch: unexpected shapes / workspace (n_in %d, ws %zu); nothing launched\n", n_in, ws_size); grid = -1; return; }
        int dev = 0, cus = 0, per_cu = 0;
        if (hipGetDevice(&dev) != hipSuccess || hipDeviceGetAttribute(&cus, hipDeviceAttributeMultiprocessorCount, dev) != hipSuccess) { grid = -1; return; }
        if (hipFuncSetAttribute((const void*)mk_fwd, hipFuncAttributeMaxDynamicSharedMemorySize, LDS_BYTES) != hipSuccess) { fprintf(stderr, "kernel_launch: hipFuncSetAttribute failed\n"); grid = -1; return; }
        if (hipOccupancyMaxActiveBlocksPerMultiprocessor(&per_cu, (const void*)mk_fwd, NWAVES * 64, LDS_BYTES) != hipSuccess || per_cu < 1) fprintf(stderr, "kernel_launch: occupancy query reports %d\n", per_cu);
        (void)hipGetLastError();
        if (cus != 256) { fprintf(stderr, "kernel_launch: built for a 256-CU device, found %d; nothing launched\n", cus); grid = -1; return; }
        grid = 256;
    }
    if (grid < 0) return;
    if (hipMemsetAsync((char*)d_ws + WS_CTL, 0, CTL_ZERO_BYTES, stream) != hipSuccess) return;
    Args a{};
    for (int i = 0; i < 29; ++i) a.in[i] = (const float*)d_in[i];
    a.out = (float*)d_out; a.ws = (unsigned char*)d_ws;
    if (N_LAUNCHES == 1) { a.ph_lo = 0; a.ph_hi = N_PHASES; hipLaunchKernelGGL(mk_fwd, dim3(grid), dim3(NWAVES * 64), LDS_BYTES, stream, a); }
    else for (int p = 0; p < N_PHASES; ++p) { a.ph_lo = p; a.ph_hi = p + 1; hipLaunchKernelGGL(mk_fwd, dim3(grid), dim3(NWAVES * 64), LDS_BYTES, stream, a); }
}
```

```cpp
#include <hip/hip_runtime.h>
#include <cstdio>
#include <cstdint>
namespace pg8 {
#define PG8_LAS __attribute__((address_space(3)))
typedef unsigned short bf16_t;
typedef short bf16x8 __attribute__((ext_vector_type(8)));
typedef float f32x4 __attribute__((ext_vector_type(4)));
typedef unsigned u32x4 __attribute__((ext_vector_type(4)));
constexpr int BM = 256, BK = 64, HALF = 128, HTB = HALF * BK * 2  , STAGE_BYTES = 8 * HTB, NXCD = 8, WGM = 8;

__host__ __device__ __forceinline__ int lds_byte(int r, int c) { const int st = (r >> 4) * 2 + (c >> 5), rr = r & 15, cc = c & 31, ob = rr * 64 + cc * 2; return st * 1024 + (ob ^ (((ob >> 9) & 1) << 5)); }
__host__ __device__ __forceinline__ void stage_rc(int b, int& R, int& C) { const int st = b / 1024, sb = b % 1024, swz = sb ^ (((sb >> 9) & 1) << 5); R = (st >> 1) * 16 + swz / 64; C = (st & 1) * 32 + (swz % 64) / 2; }
__host__ __device__ __forceinline__ int perm32(int rho) { const int n = rho >> 4, i = rho & 15; return 8 * (i >> 2) + 4 * n + (i & 3); }

struct Unit { int pm, pn; };
struct Gemm { const bf16_t* A; const bf16_t* Bt; int M, N, K; };

struct StaticOrder {
    int nM, nN, nwg, G, c;
    __host__ __device__ void init(int M, int N, int G_, int c_) { nM = M / BM; nN = N / BM; nwg = nM * nN; G = G_; c = c_; }
    __host__ __device__ bool next(int i, Unit& u) const {
        const long L = (long)i * G + c; if (L >= nwg) return false;
        int wgid = (int)L; { const int q = nwg / NXCD, r = nwg % NXCD, xcd = wgid % NXCD, off = wgid / NXCD; wgid = (xcd < r ? xcd * (q + 1) : r * (q + 1) + (xcd - r) * q) + off; }
        const int nig = WGM * nN, gid = wgid / nig, fm = gid * WGM, gsz = (nM - fm) < WGM ? (nM - fm) : WGM;
        u.pm = fm + ((wgid % nig) % gsz); u.pn = (wgid % nig) / gsz; return true;
    }
    __device__ __forceinline__ void a_ready(const Unit&) const {}
    __device__ __forceinline__ void done(const Unit&) const {}
};


__device__ __forceinline__ unsigned cvt_pk_bf16(float lo, float hi) { unsigned r; asm volatile("v_cvt_pk_bf16_f32 %0, %1, %2" : "=v"(r) : "v"(lo), "v"(hi)); return r; }
typedef unsigned u32x2 __attribute__((ext_vector_type(2)));
constexpr float QSCALE = 0.125f * 1.4426950408889634f;
constexpr float RMS_EPS = 1e-6f;
__device__ __forceinline__ float rstd_of(const f32x4 p) { return __builtin_amdgcn_rsqf(((p[0] + p[1]) + (p[2] + p[3])) * (1.0f / 1024.0f) + RMS_EPS); }
__device__ __forceinline__ float row_rstd(const float* rss, int row) { return rstd_of(*(const f32x4*)(rss + (size_t)row * 4)); }
__device__ __forceinline__ void sincos_rev(float a, float& s, float& c) {
    const float k = __builtin_rintf(a * 0.15915494309189535f);
    float r = __builtin_fmaf(-k, 6.28318548202514648f, a); r = __builtin_fmaf(-k, -1.7484555e-7f, r);
    const float x = r * 0.15915494309189535f;
    s = __builtin_amdgcn_sinf(x); c = __builtin_amdgcn_cosf(x);
}
template <int KIND> struct EpiQKV {
    static constexpr bool PERM = true, AFTER_DRAIN = false;
    bf16_t* O; int ldc; const PG8_LAS float* tb;
    __device__ __forceinline__ void operator()(const f32x4 (&acc)[2][2][4][2], const Unit& u, int wr, int wc, int fr, int fq, int ui) const {
        const int tcol = u.pn * BM;
        int sec;
        if (KIND == 2) sec = tcol < 1024 ? 0 : (tcol == 1024 ? 1 : 2); else sec = tcol >> 10;
        const int row0 = u.pm * BM + wr * 64 + fr;
        const int lc0 = tcol + 64 * wc + 8 * fq;
        const bool do_rope = (KIND != 1) && sec < 2;
        const bool do_hn = (KIND == 2) && sec < 2;
        const float qs = (sec == 0) ? QSCALE : 1.0f;
        const PG8_LAS float* rt = tb + ui * 256 + wr * 64 + fr;
        f32x4 iv[2] = {(f32x4){0.f, 0.f, 0.f, 0.f}, (f32x4){0.f, 0.f, 0.f, 0.f}};
        if (do_rope) { iv[0] = *(const PG8_LAS f32x4*)(tb + 1024 + 8 * fq); iv[1] = *(const PG8_LAS f32x4*)(tb + 1024 + 8 * fq + 4); }
        f32x4 g[2][2];
#pragma unroll
        for (int bj = 0; bj < 2; ++bj)
#pragma unroll
            for (int n = 0; n < 2; ++n) g[bj][n] = (f32x4){1.f, 1.f, 1.f, 1.f};
        if (do_hn) { const PG8_LAS float* gp = tb + 1056 + (sec == 0 ? 0 : 64);
#pragma unroll
            for (int bj = 0; bj < 2; ++bj)
#pragma unroll
                for (int n = 0; n < 2; ++n) g[bj][n] = *(const PG8_LAS f32x4*)(gp + 32 * bj + 8 * fq + 4 * n); }
#pragma unroll
        for (int ai = 0; ai < 2; ++ai)
#pragma unroll
            for (int m = 0; m < 4; ++m) {
                const int row = row0 + ai * HALF + m * 16;
                const float rstd = rt[ai * HALF + m * 16];
                f32x4 v[2][2];
#pragma unroll
                for (int bj = 0; bj < 2; ++bj)
#pragma unroll
                    for (int n = 0; n < 2; ++n) v[bj][n] = acc[ai][bj][m][n] * rstd;
                if (do_hn) {
                    float ss = 0.f;
#pragma unroll
                    for (int bj = 0; bj < 2; ++bj)
#pragma unroll
                        for (int n = 0; n < 2; ++n) { const f32x4 x = v[bj][n]; ss += (x[0] * x[0] + x[1] * x[1]) + (x[2] * x[2] + x[3] * x[3]); }
                    ss += __shfl_xor(ss, 16); ss += __shfl_xor(ss, 32);
                    const float r2 = __builtin_amdgcn_rsqf(ss * (1.0f / 64.0f) + RMS_EPS);
#pragma unroll
                    for (int bj = 0; bj < 2; ++bj)
#pragma unroll
                        for (int n = 0; n < 2; ++n) v[bj][n] = v[bj][n] * r2 * g[bj][n];
                }
                if (do_rope) {
                    const int t = row & 2047;
                    const float posf = (float)(KIND == 2 ? (fq < 2 ? (t >> 6) : (t & 63)) : t);
#pragma unroll
                    for (int n = 0; n < 2; ++n)
#pragma unroll
                        for (int e = 0; e < 4; ++e) {
                            float s, c; sincos_rev(posf * iv[n][e], s, c);
                            const float x1 = v[0][n][e], x2 = v[1][n][e];
                            v[0][n][e] = x1 * c - x2 * s; v[1][n][e] = x2 * c + x1 * s;
                        }
                }
                bf16_t* rowp = O + (size_t)row * ldc + lc0;
#pragma unroll
                for (int bj = 0; bj < 2; ++bj) {
                    const f32x4 v0 = v[bj][0] * qs, v1 = v[bj][1] * qs;
                    u32x4 w; w.x = cvt_pk_bf16(v0[0], v0[1]); w.y = cvt_pk_bf16(v0[2], v0[3]); w.z = cvt_pk_bf16(v1[0], v1[1]); w.w = cvt_pk_bf16(v1[2], v1[3]);
                    *(u32x4*)(rowp + 32 * bj) = w;
                }
            }
    }
};
template <class Sched> __device__ __forceinline__ void fill_tables(PG8_LAS float* tb, const Sched& S, const float* rss, const float* inv, const float* qg, const float* kg) {
    int tid_ = threadIdx.x; asm volatile("" : "+v"(tid_));
    Unit u;
    if (tid_ < 256) {
        f32x4 p[4]; bool ok[4];
#pragma unroll
        for (int i = 0; i < 4; ++i) { ok[i] = S.next(i, u); if (ok[i]) p[i] = *(const f32x4*)(rss + (size_t)(u.pm * BM + tid_) * 4); }
#pragma unroll
        for (int i = 0; i < 4; ++i) if (ok[i]) tb[i * 256 + tid_] = rstd_of(p[i]);
    } else if (tid_ < 288) { if (inv) tb[1024 + tid_ - 256] = inv[tid_ - 256]; }
    else if (tid_ < 352) { if (qg) tb[1056 + tid_ - 288] = qg[tid_ - 288]; }
    else if (tid_ < 416) { if (kg) tb[1120 + tid_ - 352] = kg[tid_ - 352]; }
    asm volatile("s_waitcnt vmcnt(0) lgkmcnt(0)" ::: "memory"); __builtin_amdgcn_s_barrier(); asm volatile("" ::: "memory");
}
struct EpiRes {
    static constexpr bool PERM = false, AFTER_DRAIN = true;
    bf16_t* xb; float* rss;
    __device__ __forceinline__ void fused(const f32x4 (&acc)[2][2][4][2], const Unit& u, int wr, int wc, int fr, int fq, PG8_LAS unsigned char* lds, int wid, int lane) const {
        const int row0 = u.pm * BM + wr * 64 + fr, col0 = u.pn * BM + wc * 32 + 4 * fq;
        PG8_LAS float* P = (PG8_LAS float*)lds;
        u32x2 xi[2][4][2][2];
#pragma unroll
        for (int ai = 0; ai < 2; ++ai)
#pragma unroll
            for (int m = 0; m < 4; ++m)
#pragma unroll
                for (int bj = 0; bj < 2; ++bj)
#pragma unroll
                    for (int n = 0; n < 2; ++n) xi[ai][m][bj][n] = *(const u32x2*)(xb + (size_t)(row0 + ai * HALF + m * 16) * 1024 + col0 + bj * HALF + n * 16);
#pragma unroll
        for (int ai = 0; ai < 2; ++ai)
#pragma unroll
            for (int m = 0; m < 4; ++m) {
                const int row = row0 + ai * HALF + m * 16; float ss = 0.f;
#pragma unroll
                for (int bj = 0; bj < 2; ++bj)
#pragma unroll
                    for (int n = 0; n < 2; ++n) {
                        const size_t off = (size_t)row * 1024 + col0 + bj * HALF + n * 16;
                        const u32x2 xo = xi[ai][m][bj][n]; const f32x4 a = acc[ai][bj][m][n];
                        const float x0 = __uint_as_float(xo.x << 16) + a[0], x1 = __uint_as_float(xo.x & 0xffff0000u) + a[1], x2 = __uint_as_float(xo.y << 16) + a[2], x3 = __uint_as_float(xo.y & 0xffff0000u) + a[3];
                        u32x2 w; w.x = cvt_pk_bf16(x0, x1); w.y = cvt_pk_bf16(x2, x3);
                        *(u32x2*)(xb + off) = w;
                        const float r0 = __uint_as_float(w.x << 16), r1 = __uint_as_float(w.x & 0xffff0000u), r2 = __uint_as_float(w.y << 16), r3 = __uint_as_float(w.y & 0xffff0000u);
                        ss += (r0 * r0 + r1 * r1) + (r2 * r2 + r3 * r3);
                    }
                ss += __shfl_xor(ss, 16); ss += __shfl_xor(ss, 32);
                if (fq == 0) P[(ai * HALF + wr * 64 + m * 16 + fr) * 4 + wc] = ss;
            }
        asm volatile("s_waitcnt lgkmcnt(0)" ::: "memory"); __builtin_amdgcn_s_barrier(); asm volatile("" ::: "memory");
        const int tid = wid * 64 + lane;
        if (tid < 256) { const f32x4 p = *(const PG8_LAS f32x4*)(P + tid * 4); rss[(size_t)(u.pm * BM + tid) * 4 + u.pn] = (p[0] + p[1]) + (p[2] + p[3]); }
        asm volatile("s_waitcnt lgkmcnt(0)" ::: "memory"); __builtin_amdgcn_s_barrier(); asm volatile("" ::: "memory");
    }
};
struct EpiUp {
    static constexpr bool PERM = true, AFTER_DRAIN = false;
    bf16_t* O; int ldc; const PG8_LAS float* tb;
    __device__ __forceinline__ void operator()(const f32x4 (&acc)[2][2][4][2], const Unit& u, int wr, int wc, int fr, int fq, int ui) const {
        const int row0 = u.pm * BM + wr * 64 + fr, col0 = u.pn * BM + wc * 32 + 8 * fq;
        const PG8_LAS float* rt = tb + ui * 256 + wr * 64 + fr;
#pragma unroll
        for (int ai = 0; ai < 2; ++ai)
#pragma unroll
            for (int m = 0; m < 4; ++m) {
                const int row = row0 + ai * HALF + m * 16;
                const float rstd = rt[ai * HALF + m * 16];
                bf16_t* rowp = O + (size_t)row * ldc + col0;
#pragma unroll
                for (int bj = 0; bj < 2; ++bj) {
                    f32x4 v0 = acc[ai][bj][m][0] * rstd, v1 = acc[ai][bj][m][1] * rstd;
#pragma unroll
                    for (int e = 0; e < 4; ++e) { const float a = v0[e] > 0.f ? v0[e] : 0.f, b = v1[e] > 0.f ? v1[e] : 0.f; v0[e] = a * a; v1[e] = b * b; }
                    u32x4 w; w.x = cvt_pk_bf16(v0[0], v0[1]); w.y = cvt_pk_bf16(v0[2], v0[3]); w.z = cvt_pk_bf16(v1[0], v1[1]); w.w = cvt_pk_bf16(v1[2], v1[3]);
                    *(u32x4*)(rowp + bj * HALF) = w;
                }
            }
    }
};

template <class Epi, class Sched, bool ALIGN_EPI = false, bool SP2 = false>
__device__ __forceinline__ void gemm_phase(PG8_LAS unsigned char* lds, const Gemm g, const Sched& S, const Epi& E) {
    int tid_ = threadIdx.x; asm volatile("" : "+v"(tid_));
    const int tid = tid_, wid = __builtin_amdgcn_readfirstlane(tid >> 6), lane = tid & 63, wr = wid >> 2, wc = wid & 3, fr = lane & 15, fq = lane >> 4;
    const int K = g.K, nt = K / BK;
    unsigned voffA[2], voffB[2];
#pragma unroll
    for (int i = 0; i < 2; ++i) { int R, C; stage_rc(tid * 16 + i * 8192, R, C); const int Rb = Epi::PERM ? ((R & ~31) + perm32(R & 31)) : R;
        voffA[i] = (unsigned)(R * K + C) * 2u; voffB[i] = (unsigned)(Rb * K + C) * 2u; }
    const size_t kstep = (size_t)(BK * 2);
    const size_t hstep = (size_t)HALF * K * 2;
    const size_t tstep = 2 * hstep;
    const unsigned ldsw = (unsigned)wid * 1024u;
    const int aoff = lds_byte(wr * 64 + fr, fq * 8), boff = lds_byte(wc * 32 + fr, fq * 8);
#define PG8_SA(b, h) (((b) * 2 + (h)) * HTB)
#define PG8_SB(b, h) ((4 + (b) * 2 + (h)) * HTB)
#define PG8_STAGE(bufoff, gbase, voff) do { _Pragma("unroll") for (int _i = 0; _i < 2; ++_i) \
        __builtin_amdgcn_global_load_lds((const unsigned*)((const char*)(gbase) + (voff)[_i]), (PG8_LAS unsigned*)(lds + (bufoff) + ldsw + _i * 8192), 16, 0, 0); } while (0)
#define PG8_LDA(dst, b, h) do { _Pragma("unroll") for (int m = 0; m < 4; ++m) _Pragma("unroll") for (int k = 0; k < 2; ++k) dst[m][k] = *(const PG8_LAS bf16x8*)(lds + PG8_SA(b, h) + aoff + m * 2048 + k * 1024); } while (0)
#define PG8_LDB(dst, b, h) do { _Pragma("unroll") for (int n = 0; n < 2; ++n) _Pragma("unroll") for (int k = 0; k < 2; ++k) dst[n][k] = *(const PG8_LAS bf16x8*)(lds + PG8_SB(b, h) + boff + n * 2048 + k * 1024); } while (0)
#define PG8_MMA(ai, bj, At, Bt) do { __builtin_amdgcn_s_setprio(1); _Pragma("unroll") for (int m = 0; m < 4; ++m) _Pragma("unroll") for (int n = 0; n < 2; ++n) _Pragma("unroll") for (int k = 0; k < 2; ++k) \
        acc[ai][bj][m][n] = __builtin_amdgcn_mfma_f32_16x16x32_bf16(Bt[n][k], At[m][k], acc[ai][bj][m][n], 0, 0, 0); __builtin_amdgcn_s_setprio(0); } while (0)
#define PG8_WAIT_V(n) asm volatile("s_waitcnt vmcnt(" #n ")" ::: "memory")
#define PG8_WAIT_L(n) asm volatile("s_waitcnt lgkmcnt(" #n ")" ::: "memory")
#define PG8_BAR __builtin_amdgcn_s_barrier()
#define PG8_SCHED __builtin_amdgcn_sched_barrier(0)
    Unit cur, nxt; int ui = 0;
    if (!S.next(0, cur)) return;
    f32x4 acc[2][2][4][2];
#pragma unroll
    for (int a = 0; a < 2; ++a)
#pragma unroll
        for (int b = 0; b < 2; ++b)
#pragma unroll
            for (int m = 0; m < 4; ++m)
#pragma unroll
                for (int n = 0; n < 2; ++n) acc[a][b][m][n] = (f32x4){0.f, 0.f, 0.f, 0.f};
    bf16x8 At[4][2], B0[2][2], B1[2][2];
    const char* cA = (const char*)g.A + (size_t)cur.pm * tstep; const char* cB = (const char*)g.Bt + (size_t)cur.pn * tstep;
    S.a_ready(cur);
    if constexpr (SP2) {
        PG8_STAGE(PG8_SB(0, 0), cB, voffB); PG8_STAGE(PG8_SB(0, 1), cB + hstep, voffB); PG8_STAGE(PG8_SA(0, 0), cA, voffA); PG8_STAGE(PG8_SA(0, 1), cA + hstep, voffA);
        if (wr == 1) PG8_BAR;
        PG8_WAIT_V(2); PG8_BAR;
        PG8_STAGE(PG8_SB(1, 0), cB + kstep, voffB); PG8_STAGE(PG8_SA(1, 0), cA + kstep, voffA); PG8_STAGE(PG8_SB(1, 1), cB + hstep + kstep, voffB);
        PG8_WAIT_V(6); PG8_BAR;
    } else {
        PG8_STAGE(PG8_SB(0, 0), cB, voffB); PG8_STAGE(PG8_SA(0, 0), cA, voffA); PG8_STAGE(PG8_SB(0, 1), cB + hstep, voffB); PG8_STAGE(PG8_SA(0, 1), cA + hstep, voffA);
        if (wr == 1) PG8_BAR;
        PG8_WAIT_V(4); PG8_BAR;
        PG8_STAGE(PG8_SB(1, 0), cB + kstep, voffB); PG8_STAGE(PG8_SA(1, 0), cA + kstep, voffA); PG8_STAGE(PG8_SB(1, 1), cB + hstep + kstep, voffB);
        PG8_WAIT_V(6); PG8_BAR;
    }
    for (;;) {
        const bool has_next = S.next(ui + 1, nxt);
        const char* nA = has_next ? (const char*)g.A + (size_t)nxt.pm * tstep : cA; const char* nB = has_next ? (const char*)g.Bt + (size_t)nxt.pn * tstep : cB;
        for (int t = 0; t < nt; t += 2) {
            const bool last = (t == nt - 2);
            const char* a1 = cA + (size_t)(t + 1) * kstep;
            const char* a2 = last ? nA : cA + (size_t)(t + 2) * kstep; const char* b2 = last ? nB : cB + (size_t)(t + 2) * kstep;
            const char* a3 = a2 + kstep; const char* b3 = b2 + kstep;
            if (last && has_next) S.a_ready(nxt);
            if constexpr (SP2) {
            PG8_LDB(B0, 0, 0); PG8_LDB(B1, 0, 1); PG8_SCHED; PG8_LDA(At, 0, 0); PG8_STAGE(PG8_SA(1, 1), a1 + hstep, voffA);
            PG8_WAIT_V(8); PG8_WAIT_L(0); PG8_BAR; PG8_MMA(0, 0, At, B0); PG8_MMA(0, 1, At, B1); PG8_BAR; PG8_SCHED;
            PG8_LDA(At, 0, 1); PG8_STAGE(PG8_SB(0, 0), b2, voffB); PG8_STAGE(PG8_SB(0, 1), b2 + hstep, voffB); PG8_STAGE(PG8_SA(0, 0), a2, voffA);
            PG8_WAIT_V(8); PG8_WAIT_L(0); PG8_BAR; PG8_MMA(1, 0, At, B0); PG8_MMA(1, 1, At, B1); PG8_BAR; PG8_SCHED;
            PG8_LDB(B0, 1, 0); PG8_LDB(B1, 1, 1); PG8_SCHED; PG8_LDA(At, 1, 0); PG8_STAGE(PG8_SA(0, 1), a2 + hstep, voffA);
            PG8_WAIT_V(8); PG8_WAIT_L(0); PG8_BAR; PG8_MMA(0, 0, At, B0); PG8_MMA(0, 1, At, B1); PG8_BAR; PG8_SCHED;
            PG8_LDA(At, 1, 1); PG8_STAGE(PG8_SB(1, 0), b3, voffB); PG8_STAGE(PG8_SB(1, 1), b3 + hstep, voffB); PG8_STAGE(PG8_SA(1, 0), a3, voffA);
            PG8_WAIT_V(8); PG8_WAIT_L(0); PG8_BAR; PG8_MMA(1, 0, At, B0); PG8_MMA(1, 1, At, B1); PG8_BAR; PG8_SCHED;
            } else {
            PG8_LDB(B0, 0, 0); PG8_SCHED; PG8_LDA(At, 0, 0); PG8_STAGE(PG8_SA(1, 1), a1 + hstep, voffA);
            PG8_WAIT_L(8); PG8_BAR; PG8_WAIT_L(0); PG8_MMA(0, 0, At, B0); PG8_BAR; PG8_SCHED;
            PG8_LDB(B1, 0, 1); PG8_STAGE(PG8_SB(0, 0), b2, voffB);
            PG8_BAR; PG8_WAIT_L(0); PG8_MMA(0, 1, At, B1); PG8_BAR;
            PG8_LDA(At, 0, 1); PG8_STAGE(PG8_SA(0, 0), a2, voffA);
            PG8_BAR; PG8_WAIT_L(0); PG8_MMA(1, 0, At, B0); PG8_BAR; PG8_SCHED;
            PG8_STAGE(PG8_SB(0, 1), b2 + hstep, voffB);
            PG8_WAIT_V(6); PG8_BAR; PG8_MMA(1, 1, At, B1); PG8_BAR;
            PG8_LDB(B0, 1, 0); PG8_SCHED; PG8_LDA(At, 1, 0); PG8_STAGE(PG8_SA(0, 1), a2 + hstep, voffA);
            PG8_WAIT_L(8); PG8_BAR; PG8_WAIT_L(0); PG8_MMA(0, 0, At, B0); PG8_BAR; PG8_SCHED;
            PG8_LDB(B1, 1, 1); PG8_STAGE(PG8_SB(1, 0), b3, voffB);
            PG8_BAR; PG8_WAIT_L(0); PG8_MMA(0, 1, At, B1); PG8_BAR;
            PG8_LDA(At, 1, 1); PG8_STAGE(PG8_SA(1, 0), a3, voffA);
            PG8_BAR; PG8_WAIT_L(0); PG8_MMA(1, 0, At, B0); PG8_BAR; PG8_SCHED;
            PG8_STAGE(PG8_SB(1, 1), b3 + hstep, voffB);
            PG8_WAIT_V(6); PG8_BAR; PG8_MMA(1, 1, At, B1); PG8_BAR;
            }
        }
        if constexpr (ALIGN_EPI) { if (wr == 0) PG8_BAR; }
        if constexpr (!Epi::AFTER_DRAIN) { E(acc, cur, wr, wc, fr, fq, ui); S.done(cur); }
        if (!has_next) break;
#pragma unroll
        for (int a = 0; a < 2; ++a)
#pragma unroll
            for (int b = 0; b < 2; ++b)
#pragma unroll
                for (int m = 0; m < 4; ++m)
#pragma unroll
                    for (int n = 0; n < 2; ++n) acc[a][b][m][n] = (f32x4){0.f, 0.f, 0.f, 0.f};
        cur = nxt; cA = nA; cB = nB; ++ui;
        if constexpr (ALIGN_EPI) { if (wr == 1) PG8_BAR; }
    }
    PG8_WAIT_V(0);
    if constexpr (!ALIGN_EPI) { if (wr == 0) PG8_BAR; }
    PG8_BAR;
    if constexpr (Epi::AFTER_DRAIN) { E.fused(acc, cur, wr, wc, fr, fq, lds, wid, lane); S.done(cur); }
#undef PG8_SA
#undef PG8_SB
#undef PG8_STAGE
#undef PG8_LDA
#undef PG8_LDB
#undef PG8_MMA
#undef PG8_WAIT_V
#undef PG8_WAIT_L
#undef PG8_BAR
#undef PG8_SCHED
}
}
#define GAS __attribute__((address_space(1)))
#define LAS __attribute__((address_space(3)))
typedef unsigned short bf16;
typedef unsigned v4u __attribute__((ext_vector_type(4)));
typedef float f32x4 __attribute__((ext_vector_type(4)));
typedef short bf16x8 __attribute__((ext_vector_type(8)));
typedef GAS unsigned gu32;
typedef GAS unsigned long long gu64;
#define RLX_AGENT __ATOMIC_RELAXED, __HIP_MEMORY_SCOPE_AGENT
#define LDS_WAIT() asm volatile("s_waitcnt lgkmcnt(0)" ::: "memory")
#define VM_WAIT() asm volatile("s_waitcnt vmcnt(0)" ::: "memory")
__device__ __forceinline__ unsigned long long rt() { return __builtin_amdgcn_s_memrealtime(); }
__device__ __forceinline__ unsigned f2bf(float f) { unsigned u = __builtin_bit_cast(unsigned, f); return (u + 0x7fffu + ((u >> 16) & 1u)) >> 16; }
__device__ __forceinline__ unsigned pk2(float lo, float hi) { return f2bf(lo) | (f2bf(hi) << 16); }

#define XB_TMO      128
#define XB_XCNT(j)  (256  + 64 * (j))
#define XB_XSUB(j)  (1280 + 64 * (j))
#define XB_XGEN(j)  (2304 + 64 * (j))
#define XB_TOP      3328
#define XB_TOPGEN   3392
#define XCD_BAR_WORDS 3456
#define XB_SPIN_CAP (1u << 18)

__device__ __forceinline__ unsigned xb_ld(unsigned* p)              { return __hip_atomic_load(p, __ATOMIC_RELAXED, __HIP_MEMORY_SCOPE_AGENT); }
__device__ __forceinline__ unsigned xb_add(unsigned* p, unsigned v) { return __hip_atomic_fetch_add(p, v, __ATOMIC_RELAXED, __HIP_MEMORY_SCOPE_AGENT); }
__device__ __forceinline__ unsigned xb_xcc_id() { return (unsigned)__builtin_amdgcn_s_getreg((3 << 11) | 20) & 0xFu; }
#define XB_SPIN(cond, bar) do { unsigned _sp = 0; while (cond) { __builtin_amdgcn_s_sleep(1); \
    if ((++_sp & 255u) == 0u) { if (xb_ld(&(bar)[XB_TMO])) break; if (_sp > XB_SPIN_CAP) { atomicAdd(&(bar)[XB_TMO], 1u); break; } } } } while (0)

struct XcdBarrier {
    unsigned* bar; unsigned x;
    volatile LAS unsigned* st;
};

__device__ __forceinline__ XcdBarrier xcd_barrier_post(unsigned* bar, volatile LAS unsigned* st) {
    XcdBarrier b; b.bar = bar; b.x = xb_xcc_id(); b.st = st;
    if (threadIdx.x == 0) (void)xb_add(&bar[XB_XCNT(b.x)], 1u);
    return b;
}
__device__ __forceinline__ void xcd_barrier_complete(unsigned* bar, unsigned x, unsigned& nloc, unsigned& nx) {
    const unsigned G = gridDim.x * gridDim.y * gridDim.z;
    unsigned sum, cnt, mine, sp = 0u;
    for (;;) {
        sum = 0u; cnt = 0u; mine = 0u;
#pragma unroll
        for (unsigned j = 0; j < 16; ++j) { const unsigned c = xb_ld(&bar[XB_XCNT(j)]); sum += c; cnt += (c > 0u) ? 1u : 0u; mine = (j == x) ? c : mine; }
        if (sum == G) break;
        __builtin_amdgcn_s_sleep(1);
        if ((++sp & 255u) == 0u) { if (xb_ld(&bar[XB_TMO])) break; if (sp > XB_SPIN_CAP) { atomicAdd(&bar[XB_TMO], 1u); break; } }
    }
    nloc = mine > 0u ? mine : 1u; nx = cnt > 0u ? cnt : 1u;
}

__device__ __forceinline__ void xcd_barrier(const XcdBarrier& b) {
    asm volatile("s_waitcnt vmcnt(0)" ::: "memory");
    __syncthreads();
    if (threadIdx.x == 0) {
        unsigned* bar = b.bar;
        __builtin_amdgcn_s_waitcnt(0);
        unsigned nloc = b.st[0], nx = b.st[1];
        if (nloc == 0u) { xcd_barrier_complete(bar, b.x, nloc, nx); b.st[0] = nloc; b.st[1] = nx; }
        const unsigned old = xb_add(&bar[XB_XSUB(b.x)], 1u);
        const unsigned gen = old / nloc;
        if (old + 1u == (gen + 1u) * nloc) {
            __builtin_amdgcn_fence(__ATOMIC_RELEASE, "agent");
            asm volatile("s_waitcnt vmcnt(0)" ::: "memory");
            const unsigned og = xb_add(&bar[XB_TOP], 1u);
            const unsigned tg = og / nx;
            if (og + 1u == (tg + 1u) * nx) xb_add(&bar[XB_TOPGEN], 1u);
            else XB_SPIN(xb_ld(&bar[XB_TOPGEN]) == tg, bar);
            __builtin_amdgcn_fence(__ATOMIC_ACQUIRE, "agent");
            xb_add(&bar[XB_XGEN(b.x)], 1u);
            asm volatile("s_waitcnt vmcnt(0)" ::: "memory");
        } else {
            XB_SPIN(xb_ld(&bar[XB_XGEN(b.x)]) == gen, bar);
            __builtin_amdgcn_fence(__ATOMIC_ACQUIRE, "agent");
            asm volatile("s_waitcnt vmcnt(0)" ::: "memory");
        }
    }
    __syncthreads();
}
#include <hip/hip_bf16.h>
#include <cmath>
namespace attc {
using bf16=__hip_bfloat16;
using bf16x8=__attribute__((ext_vector_type(8)))short;
using s16x4=__attribute__((ext_vector_type(4)))short;
using f32x16=__attribute__((ext_vector_type(16)))float;
using u32x4=__attribute__((ext_vector_type(4)))unsigned;
constexpr int BATCH=8,NHEAD=16,SEQ=2048,D=64,QP=1536,KP=1536,OP=1024;
constexpr int NW=8,QBLK=32,QB=QBLK*NW,KVBLK=64,NQB=SEQ/QB;
constexpr int ATTN_UNIT_ROWS=QB;
__device__ __forceinline__ int crow(int r,int hi){return (r&3)+8*(r>>2)+4*hi;}
#define SBAR() __builtin_amdgcn_sched_barrier(0)
__device__ __forceinline__ void cmask(f32x16&p0,f32x16&p1,int jb,int qrel,int hi){
  const float NEG=-INFINITY; int kb=64*jb+4*hi;
  #pragma unroll
  for(int r=0;r<16;++r){int kv=kb+(r&3)+8*(r>>2); if(kv>qrel)p0[r]=NEG; if(kv+32>qrel)p1[r]=NEG;}
}

constexpr int NSLOT=3, SLOTB=8192;
constexpr int LDS_K=0, LDS_V=NSLOT*SLOTB, LDS_WS=2*NSLOT*SLOTB, LDS_OST=LDS_WS+NW*64*4, LDS_BYTES=LDS_OST+NW*4096;
constexpr float C2=0.125f*1.4426950408889634f;
__device__ __forceinline__ void glds16(const void*gsrc,unsigned lds_dst){unsigned keep;
  asm volatile("s_mov_b32 %0, m0\n\ts_mov_b32 m0, %2\n\ts_nop 0\n\tglobal_load_lds_dwordx4 %1, off\n\ts_mov_b32 m0, %0":"=&s"(keep):"v"(gsrc),"s"(lds_dst):"memory");}
__device__ __forceinline__ float max3f(float a,float b,float c){float r;asm("v_max3_f32 %0, %1, %2, %3":"=v"(r):"v"(a),"v"(b),"v"(c));return r;}
__device__ __forceinline__ float max2f(float a,float b){float r;asm("v_max_f32_e32 %0, %1, %2":"=v"(r):"v"(a),"v"(b));return r;}
__device__ __forceinline__ float fadd_s(float a,float b){float r;asm("v_add_f32_e32 %0, %1, %2":"=v"(r):"v"(a),"v"(b));return r;}
__device__ __forceinline__ float fsub_s(float a,float b){float r;asm("v_sub_f32_e32 %0, %1, %2":"=v"(r):"v"(a),"v"(b));return r;}
typedef float f32x2_t __attribute__((ext_vector_type(2))); typedef __bf16 bf16x2_t __attribute__((ext_vector_type(2)));
__device__ __forceinline__ unsigned cvtpk_s(float lo,float hi){f32x2_t v={lo,hi};bf16x2_t b=__builtin_convertvector(v,bf16x2_t);return __builtin_bit_cast(unsigned,b);}
#define WAIT_BAR(N) asm volatile("s_waitcnt vmcnt(" #N ") lgkmcnt(0)\n\ts_barrier":::"memory")

__device__ __forceinline__ void qkt(f32x16&p0,f32x16&p1,const char*Kslot,const bf16x8*qr,const f32x16&negm,int r32,int hi){
  const char*kb=Kslot+hi*1024+r32*16;
  #pragma unroll
  for(int d0=0;d0<4;++d0){
    const bf16x8 b0=*reinterpret_cast<const bf16x8*>(kb+d0*2048);
    const bf16x8 b1=*reinterpret_cast<const bf16x8*>(kb+d0*2048+512);
    if(d0==0){p0=__builtin_amdgcn_mfma_f32_32x32x16_bf16(b0,qr[0],negm,0,0,0);p1=__builtin_amdgcn_mfma_f32_32x32x16_bf16(b1,qr[0],negm,0,0,0);}
    else{p0=__builtin_amdgcn_mfma_f32_32x32x16_bf16(b0,qr[d0],p0,0,0,0);p1=__builtin_amdgcn_mfma_f32_32x32x16_bf16(b1,qr[d0],p1,0,0,0);}}
}
typedef __attribute__((address_space(3))) const char* lds_cptr;
typedef short v4i16_t __attribute__((ext_vector_type(4)));
__device__ __forceinline__ void kload8(bf16x8*kf,lds_cptr kp){
  kf[0]=*(const __attribute__((address_space(3))) bf16x8*)(kp);      kf[1]=*(const __attribute__((address_space(3))) bf16x8*)(kp+512);
  kf[2]=*(const __attribute__((address_space(3))) bf16x8*)(kp+2048); kf[3]=*(const __attribute__((address_space(3))) bf16x8*)(kp+2560);
  kf[4]=*(const __attribute__((address_space(3))) bf16x8*)(kp+4096); kf[5]=*(const __attribute__((address_space(3))) bf16x8*)(kp+4608);
  kf[6]=*(const __attribute__((address_space(3))) bf16x8*)(kp+6144); kf[7]=*(const __attribute__((address_space(3))) bf16x8*)(kp+6656);
}
__device__ __forceinline__ void kload2(bf16x8*kf,lds_cptr kp,int j){ kf[2*j]=*(const __attribute__((address_space(3))) bf16x8*)(kp+j*2048); kf[2*j+1]=*(const __attribute__((address_space(3))) bf16x8*)(kp+j*2048+512); }
__device__ __forceinline__ s16x4 vtr(lds_cptr p){ return __builtin_bit_cast(s16x4,__builtin_amdgcn_ds_read_tr16_b64_v4i16((__attribute__((address_space(3))) v4i16_t*)p)); }
__device__ __forceinline__ float rowmax(const f32x16&p0,const f32x16&p1){
  float a=max3f(p0[0],p0[1],p1[0]),b=max3f(p0[2],p0[3],p1[1]);a=max3f(a,p1[2],p1[3]);
  #pragma unroll
  for(int r=4;r<16;r+=4){a=max3f(a,p0[r],p0[r+1]);b=max3f(b,p0[r+2],p0[r+3]);a=max3f(a,p1[r],p1[r+1]);b=max3f(b,p1[r+2],p1[r+3]);}
  const float m=max2f(a,b);
  auto rr=__builtin_amdgcn_permlane32_swap(__float_as_uint(m),__float_as_uint(m),false,false);
  return max2f(__uint_as_float(rr[0]),__uint_as_float(rr[1]));
}
__device__ __forceinline__ void pv(f32x16*o,int vb,bf16x8 pa0,bf16x8 pa1,bf16x8 pa2,bf16x8 pa3){
  #pragma unroll
  for(int d0=0;d0<2;++d0){s16x4 lo[4],hi[4];
    #pragma unroll
    for(int ks=0;ks<4;++ks){
      asm volatile("ds_read_b64_tr_b16 %0,%1 offset:%c2":"=&v"(lo[ks]):"v"(vb),"i"(d0*4096+ks*1024):"memory");
      asm volatile("ds_read_b64_tr_b16 %0,%1 offset:%c2":"=&v"(hi[ks]):"v"(vb),"i"(d0*4096+ks*1024+512):"memory");}
    asm volatile("s_waitcnt lgkmcnt(0)":::"memory");SBAR();
    #define PK(k) (bf16x8){lo[k][0],lo[k][1],lo[k][2],lo[k][3],hi[k][0],hi[k][1],hi[k][2],hi[k][3]}
    o[d0]=__builtin_amdgcn_mfma_f32_32x32x16_bf16(pa0,PK(0),o[d0],0,0,0);
    o[d0]=__builtin_amdgcn_mfma_f32_32x32x16_bf16(pa1,PK(1),o[d0],0,0,0);
    o[d0]=__builtin_amdgcn_mfma_f32_32x32x16_bf16(pa2,PK(2),o[d0],0,0,0);
    o[d0]=__builtin_amdgcn_mfma_f32_32x32x16_bf16(pa3,PK(3),o[d0],0,0,0);
    #undef PK
  }
}

#ifndef ATTN_STORE16
#define ATTN_STORE16(p,v) (*(u32x4*)(p)=(v))
#endif
template<int THRL> __device__ __forceinline__ void attn_unit(int b,int h,int hk,int qb,const bf16*Q,const bf16*__restrict__ K,const bf16*__restrict__ V,bf16*O,char*shm){
  int tid_=threadIdx.x; asm volatile("":"+v"(tid_));
  const int tid=tid_,lane=tid&63,r32=lane&31,hi=lane>>5; const int wid=__builtin_amdgcn_readfirstlane(tid>>6);
  const long rowbase=(long)b*SEQ; const int q0=qb*QB;
  const bf16*Qw=Q+(rowbase+q0+wid*QBLK)*QP+h*D;
  const bf16*Kh=K+rowbase*KP+hk*D,*Vh=V+rowbase*KP+hk*D;
  const unsigned lds0=(unsigned)(uintptr_t)shm;
  float*wsf=(float*)(shm+LDS_WS)+wid*64;
  const bf16*ksrc=Kh+(long)lane*KP+wid*8;
  const bf16*vsrc=Vh+(long)(16*(wid&3)+(lane>>2))*KP+(wid>>2)*32+(lane&3)*8;
  const unsigned kdst=lds0+LDS_K+wid*1024, vdst=lds0+LDS_V+wid*1024;
  #define DMA_K(t,slot) glds16(ksrc+(long)(t)*KVBLK*KP,(unsigned)__builtin_amdgcn_readfirstlane(kdst+(slot)))
  #define DMA_V(t,slot) glds16(vsrc+(long)(t)*KVBLK*KP,(unsigned)__builtin_amdgcn_readfirstlane(vdst+(slot)))
  const int vb0=(int)(lds0+LDS_V)+((lane>>4)&1)*32+(lane&3)*8+(4*hi+((lane&15)>>2))*64;
  const char*Kbase=shm+LDS_K; bf16x8 kf[8];
  const lds_cptr shm3=(lds_cptr)shm; const lds_cptr kp0=shm3+LDS_K+hi*1024+r32*16; const lds_cptr vp0=shm3+LDS_V+((lane>>4)&1)*32+(lane&3)*8+(4*hi+((lane&15)>>2))*64;
  const int NT=SEQ/KVBLK;
  DMA_K(0,0);DMA_V(0,0);DMA_K(1,SLOTB);
  bf16x8 qr[4];
  #pragma unroll
  for(int d0=0;d0<4;++d0)qr[d0]=*reinterpret_cast<const bf16x8*>(&Qw[(long)r32*QP+d0*16+hi*8]);
  float mhat=0.f,l_reg=0.f;f32x16 o[2];o[0]=f32x16{};o[1]=f32x16{};f32x16 negm=f32x16{};asm volatile("":"+v"(negm));
  const int qrel=wid*QBLK+r32;
  #define CMASK(P0,P1,t) do{}while(0)
  bool resc=false;
  #define START(P0,P1) do{ const float rm=rowmax(P0,P1); resc=false; \
    { const float dl=rm; mhat=fadd_s(mhat,dl); \
      _Pragma("unroll") for(int r=0;r<16;++r){P0[r]=fsub_s(P0[r],dl);P1[r]=fsub_s(P1[r],dl);} \
      _Pragma("unroll") for(int r=0;r<16;++r)negm[r]=-mhat; asm volatile("":"+v"(negm)); } \
    _Pragma("unroll") for(int r=0;r<16;++r)P0[r]=__builtin_amdgcn_exp2f(P0[r]); }while(0)
  #define RESC() do{ if(resc){ asm volatile("s_waitcnt lgkmcnt(0)":::"memory"); \
      _Pragma("unroll") for(int d_=0;d_<2;++d_) _Pragma("unroll") for(int r=0;r<16;++r)o[d_][r]*=wsf[crow(r,hi)]; } }while(0)
  f32x16 pA0,pA1,pB0,pB1;
  int sl_prev=0,sl_cur=0,sl_next=SLOTB;
  #define ROT() do{sl_prev=sl_cur;sl_cur=sl_next;sl_next=(sl_next==(NSLOT-1)*SLOTB)?0:sl_next+SLOTB;}while(0)
  DMA_K(2,2*SLOTB);
  WAIT_BAR(3);
  qkt(pA0,pA1,Kbase,qr,negm,r32,hi);asm volatile("s_nop 15\n\ts_nop 7":"+v"(pA0),"+v"(pA1));CMASK(pA0,pA1,0);
  START(pA0,pA1);
  _Pragma("unroll") for(int r=0;r<16;++r)pA1[r]=__builtin_amdgcn_exp2f(pA1[r]);
  WAIT_BAR(0);
  DMA_K(3,0);DMA_V(1,SLOTB);
  ROT();
  kload8(kf,kp0+sl_cur);
  WAIT_BAR(2);
  s16x4 vlo[8],vhi[8]; u32x4 pw0,pw1,pw2,pw3;
  #define PKW(P,B) cvtpk_s(P[B],P[B+1])
  #define PAF(k) __builtin_bit_cast(bf16x8,pw##k)
  #define VFR(i) (bf16x8){vlo[i][0],vlo[i][1],vlo[i][2],vlo[i][3],vhi[i][0],vhi[i][1],vhi[i][2],vhi[i][3]}
  #define PIN(x) asm volatile("":"+v"(x))
  #define MX3(a,b,c) __builtin_fmaxf(__builtin_fmaxf((a),(b)),(c))
  #define GAPA(MF,A0,A1,A2,A3,W0,W1,PW) do{ MF; sacc+=A0; sacc+=A1; sacc+=A2; sacc+=A3; PIN(sacc); W0; W1; PIN(PW); SBAR(); }while(0)
  #define EX(v) __builtin_amdgcn_exp2f(v)
  #define GAPB(MF,X,B) do{ MF; X[B]=EX(X[B]); X[B+1]=EX(X[B+1]); X[B+2]=EX(X[B+2]); X[B+3]=EX(X[B+3]); PIN(X); SBAR(); }while(0)
  #define VRD(i) do{ vlo[i]=vtr(vp_+(((i)>>2)*4096+((i)&3)*1024)); vhi[i]=vtr(vp_+(((i)>>2)*4096+((i)&3)*1024+512)); }while(0)
  #define KRD(G,j) do{ if(G){ kload2(kf,kp0+sl_next,j); SBAR(); } }while(0)
  #define STEP(C0,C1,P0,P1,t,GK,GV,GL) do{ SBAR(); \
    const lds_cptr vp_=vp0+sl_prev; \
    VRD(0); SBAR(); float sacc=(P0[0]+P0[1]); \
    GAPA(C0=__builtin_amdgcn_mfma_f32_32x32x16_bf16(kf[0],qr[0],negm,0,0,0), P0[2],P0[3],P0[4],P0[5],     pw0[0]=PKW(P0,0), pw0[1]=PKW(P0,2), pw0); \
    VRD(4); SBAR(); GAPA(C1=__builtin_amdgcn_mfma_f32_32x32x16_bf16(kf[1],qr[0],negm,0,0,0), P0[6],P0[7],P0[8],P0[9],     pw0[2]=PKW(P0,4), pw0[3]=PKW(P0,6), pw0); \
    VRD(1); SBAR(); GAPA(C0=__builtin_amdgcn_mfma_f32_32x32x16_bf16(kf[2],qr[1],C0,0,0,0),   P0[10],P0[11],P0[12],P0[13], pw1[0]=PKW(P0,8), pw1[1]=PKW(P0,10), pw1); \
    VRD(5); SBAR(); GAPA(C1=__builtin_amdgcn_mfma_f32_32x32x16_bf16(kf[3],qr[1],C1,0,0,0),   P0[14],P0[15],P1[0],P1[1],   pw1[2]=PKW(P0,12),pw1[3]=PKW(P0,14), pw1); \
    VRD(2); SBAR(); GAPA(C0=__builtin_amdgcn_mfma_f32_32x32x16_bf16(kf[4],qr[2],C0,0,0,0),   P1[2],P1[3],P1[4],P1[5],     pw2[0]=PKW(P1,0), pw2[1]=PKW(P1,2), pw2); \
    VRD(6); SBAR(); GAPA(C1=__builtin_amdgcn_mfma_f32_32x32x16_bf16(kf[5],qr[2],C1,0,0,0),   P1[6],P1[7],P1[8],P1[9],     pw2[2]=PKW(P1,4), pw2[3]=PKW(P1,6), pw2); \
    VRD(3); SBAR(); GAPA(C0=__builtin_amdgcn_mfma_f32_32x32x16_bf16(kf[6],qr[3],C0,0,0,0),   P1[10],P1[11],P1[12],P1[13], pw3[0]=PKW(P1,8), pw3[1]=PKW(P1,10), pw3); \
    VRD(7); SBAR(); GAPA(C1=__builtin_amdgcn_mfma_f32_32x32x16_bf16(kf[7],qr[3],C1,0,0,0),   P1[14],P1[15],0.f,0.f,       pw3[2]=PKW(P1,12),pw3[3]=PKW(P1,14), pw3); \
    l_reg+=sacc; \
    if(GK){DMA_K((t)+3,sl_cur);} if(GV){DMA_V((t)+1,sl_next);} \
    CMASK(C0,C1,t); \
    { float a=MX3(C0[0],C0[1],C1[0]),b=MX3(C0[2],C0[3],C1[1]); a=MX3(a,C1[2],C1[3]); \
      _Pragma("unroll") for(int r=4;r<16;r+=4){a=MX3(a,C0[r],C0[r+1]);b=MX3(b,C0[r+2],C0[r+3]);a=MX3(a,C1[r],C1[r+1]);b=MX3(b,C1[r+2],C1[r+3]);} \
      float rm=__builtin_fmaxf(a,b); { auto rr=__builtin_amdgcn_permlane32_swap(__float_as_uint(rm),__float_as_uint(rm),false,false); rm=__builtin_fmaxf(__uint_as_float(rr[0]),__uint_as_float(rr[1])); } \
      resc=false; \
      if(__builtin_expect(__any(rm>(float)THRL),0)){ const float dl=__builtin_fmaxf(rm,0.f); mhat+=dl; \
        _Pragma("unroll") for(int r=0;r<16;++r){C0[r]-=dl;C1[r]-=dl;} \
        _Pragma("unroll") for(int r=0;r<16;++r)negm[r]=-mhat; asm volatile("":"+v"(negm)); \
        const float f=__builtin_amdgcn_exp2f(-dl); l_reg*=f; if(hi==0)wsf[r32]=f; resc=true; } } \
    SBAR(); \
    GAPB(o[0]=__builtin_amdgcn_mfma_f32_32x32x16_bf16(PAF(0),VFR(0),o[0],0,0,0), C0,0); \
    GAPB(o[1]=__builtin_amdgcn_mfma_f32_32x32x16_bf16(PAF(0),VFR(4),o[1],0,0,0), C0,4); \
    KRD(GL,0); GAPB(o[0]=__builtin_amdgcn_mfma_f32_32x32x16_bf16(PAF(1),VFR(1),o[0],0,0,0), C0,8); \
    KRD(GL,1); GAPB(o[1]=__builtin_amdgcn_mfma_f32_32x32x16_bf16(PAF(1),VFR(5),o[1],0,0,0), C0,12); \
    KRD(GL,2); GAPB(o[0]=__builtin_amdgcn_mfma_f32_32x32x16_bf16(PAF(2),VFR(2),o[0],0,0,0), C1,0); \
    KRD(GL,3); GAPB(o[1]=__builtin_amdgcn_mfma_f32_32x32x16_bf16(PAF(2),VFR(6),o[1],0,0,0), C1,4); \
    GAPB(o[0]=__builtin_amdgcn_mfma_f32_32x32x16_bf16(PAF(3),VFR(3),o[0],0,0,0), C1,8); \
    GAPB(o[1]=__builtin_amdgcn_mfma_f32_32x32x16_bf16(PAF(3),VFR(7),o[1],0,0,0), C1,12); \
    }while(0)
  int t=1;
  #undef CMASK
  #define CMASK(P0,P1,t) do{}while(0)
  for(;t+5<NT;t+=2){
    STEP(pB0,pB1,pA0,pA1,t,true,true,true);     WAIT_BAR(2); RESC(); ROT();
    STEP(pA0,pA1,pB0,pB1,t+1,true,true,true);   WAIT_BAR(2); RESC(); ROT();
  }
  #undef CMASK
  #define CMASK(P0,P1,t) do{}while(0)
  #define ENDW(tt) do{ if((tt)+3<NT){WAIT_BAR(2);} else if((tt)+2<NT){WAIT_BAR(1);} else {WAIT_BAR(0);} }while(0)
  for(;t+1<NT;t+=2){
    STEP(pB0,pB1,pA0,pA1,t,(t+3<NT),(t+1<NT),(t+1<NT));       ENDW(t);   RESC(); ROT();
    STEP(pA0,pA1,pB0,pB1,t+1,(t+4<NT),(t+2<NT),(t+2<NT));     ENDW(t+1); RESC(); ROT();
  }
  STEP(pB0,pB1,pA0,pA1,NT-1,false,false,false); RESC();
  { float sacc=pB0[0]+pB0[1]; _Pragma("unroll") for(int r=2;r<16;++r)sacc+=pB0[r]; _Pragma("unroll") for(int r=0;r<16;++r)sacc+=pB1[r]; l_reg+=sacc;
    pw0=(u32x4){PKW(pB0,0),PKW(pB0,2),PKW(pB0,4),PKW(pB0,6)};pw1=(u32x4){PKW(pB0,8),PKW(pB0,10),PKW(pB0,12),PKW(pB0,14)};pw2=(u32x4){PKW(pB1,0),PKW(pB1,2),PKW(pB1,4),PKW(pB1,6)};pw3=(u32x4){PKW(pB1,8),PKW(pB1,10),PKW(pB1,12),PKW(pB1,14)};
    SBAR(); pv(o,vb0+sl_cur,PAF(0),PAF(1),PAF(2),PAF(3)); }
  #undef PKW
  #undef PAF
  #undef VFR
  #undef PIN
  #undef MX3
  #undef GAPA
  #undef GAPB
  #undef EX
  #undef VRD
  #undef KRD
  #undef STEP
  #undef ENDW
  {auto rr=__builtin_amdgcn_permlane32_swap(__float_as_uint(l_reg),__float_as_uint(l_reg),false,false);l_reg=__uint_as_float(rr[0])+__uint_as_float(rr[1]);}
  if(hi==0)wsf[32+r32]=l_reg;asm volatile("s_waitcnt lgkmcnt(0)":::"memory");
  float rli[16];
  #pragma unroll
  for(int r=0;r<16;++r)rli[r]=__builtin_amdgcn_rcpf(wsf[32+crow(r,hi)]);
  bf16*Ow=O+(rowbase+q0+wid*QBLK)*OP+h*D;
  { bf16*stg=(bf16*)(shm+LDS_OST)+wid*2048;
    #pragma unroll
    for(int r=0;r<16;++r){const int orow=crow(r,hi);
      #pragma unroll
      for(int d0=0;d0<2;++d0)stg[orow*64+d0*32+r32]=__float2bfloat16(o[d0][r]*rli[r]);}
    asm volatile("s_waitcnt lgkmcnt(0)":::"memory");
    #pragma unroll
    for(int i=0;i<4;++i){const int row=i*8+(lane>>3),ch=lane&7; const u32x4 v=*(const u32x4*)(stg+row*64+ch*8); ATTN_STORE16(Ow+(long)row*OP+ch*8,v);} }
  asm volatile("s_waitcnt lgkmcnt(0)\n\ts_barrier":::"memory");
  #undef DMA_K
  #undef DMA_V
  #undef CMASK
  #undef START
  #undef RESC
  #undef ROT
}
constexpr int ATTN_LDS_BYTES=LDS_BYTES;
struct AttnTensors { const bf16* Q; const bf16* K; const bf16* V; bf16* O; };
template<int THRL=8> __device__ __forceinline__ void attn_phase(char*lds,const AttnTensors&T,int vcu){
  const int grp=vcu>>3,j=vcu&7,b=grp>>2,hk=grp&3,h=hk*4+(j>>1);
  for(int i=0;i<4;++i) attn_unit<THRL>(b,h,hk,(j&1)*4+i,T.Q,T.K,T.V,T.O,lds);
}
#undef SBAR
#undef WAIT_BAR
}

namespace att {
typedef short bf16x8 __attribute__((ext_vector_type(8)));
typedef short s16x4 __attribute__((ext_vector_type(4)));
typedef short v4i16_t __attribute__((ext_vector_type(4)));
typedef float f32x16 __attribute__((ext_vector_type(16)));
typedef unsigned u32x4 __attribute__((ext_vector_type(4)));
typedef unsigned u32x2 __attribute__((ext_vector_type(2)));
typedef float f32x2_t __attribute__((ext_vector_type(2))); typedef __bf16 bf16x2_t __attribute__((ext_vector_type(2)));
typedef unsigned short bf16_t;
#define ALAS __attribute__((address_space(3)))
constexpr float LOG2E = 1.4426950408889634f;
__device__ __forceinline__ int crow(int r, int hi) { return (r & 3) + 8 * (r >> 2) + 4 * hi; }
__device__ __forceinline__ unsigned cvtpk(float lo, float hi) { f32x2_t v = {lo, hi}; bf16x2_t b = __builtin_convertvector(v, bf16x2_t); return __builtin_bit_cast(unsigned, b); }
__device__ __forceinline__ s16x4 vtr(const ALAS unsigned char* p) { return __builtin_bit_cast(s16x4, __builtin_amdgcn_ds_read_tr16_b64_v4i16((ALAS v4i16_t*)p)); }
__device__ __forceinline__ int clampi(int v, int lo, int hi) { return v < lo ? lo : (v > hi ? hi : v); }

struct AttnP { const bf16_t* Q; const bf16_t* K; const bf16_t* V; int pitch; bf16_t* O; float* lse; const float* rpb; int dlog; int g; };

constexpr int WAVE_LDS = 8192;

template <int MODE>
__device__ __forceinline__ void attn_unit(const AttnP& P, int u, ALAS unsigned char* wl, int lane_) {
    int lane = lane_; asm volatile("" : "+v"(lane));
    const int q = lane & 31, hi = lane >> 5;
    int b, h, hk, qtok, tok0, tstep, kstr, nt, jt0;
    int rq = 0, cq = 0, kstart = 0;
    if (MODE == 0) {
        const int dlog = P.dlog, d = 1 << dlog, nblk = 64 >> dlog;
        h = u & 15; int rest = u >> 4; const int blk = rest & (nblk - 1); rest >>= (6 - dlog); const int r = rest & (d - 1); b = rest >> dlog; hk = h;
        const int i0 = 32 * blk, L = 2048 >> dlog;
        qtok = b * 2048 + ((i0 + q) << dlog) + r;
        const int jlo = (i0 < 64) ? ((64 - i0) >> 5) : 0; int jhi = (L - i0 + 64) >> 5; if (jhi > 5) jhi = 5;
        jt0 = jlo; nt = jhi - jlo;
        tok0 = b * 2048 + ((i0 - 64 + 32 * jlo) << dlog) + r; tstep = 32 << dlog; kstr = d;
    } else if (MODE == 1) {
        h = u & 15; const int rest = u >> 4; const int cb = rest & 3, rp = (rest >> 2) & 15; b = rest >> 6; hk = h;
        rq = 2 * rp + (q >> 4); cq = 16 * cb + (q & 15);
        qtok = b * 2048 + rq * 64 + cq;
        kstart = clampi(16 * cb - 8, 0, 32);
        const int rs0 = clampi(2 * rp - 4, 0, 24), rs1 = clampi(2 * rp - 3, 0, 24);
        jt0 = rs0; nt = rs1 + 8 - rs0;
        tok0 = b * 2048 + rs0 * 64 + kstart; tstep = 64; kstr = 1;
    } else {
        const int qblk = u & 63; h = (u >> 6) & 15; b = u >> 10; hk = h >> 2;
        qtok = b * 2048 + 32 * qblk + q; jt0 = 0; nt = 64; tok0 = b * 2048; tstep = 32; kstr = 1;
    }
    const int pitch = P.pitch;
    ALAS float* tab = (ALAS float*)(wl + 4096);
    if (MODE == 1) {
#pragma unroll
        for (int k = 0; k < 8; ++k) { const int i = lane + 64 * k; if (i < 465) tab[i] = P.rpb[h * 465 + i] * LOG2E; }
    }
    bf16x8 qf[4];
    { const bf16_t* qp = P.Q + (size_t)qtok * pitch + h * 64 + hi * 8;
#pragma unroll
      for (int ks = 0; ks < 4; ++ks) qf[ks] = *(const bf16x8*)(qp + 16 * ks); }
    const bf16_t* kp = P.K + hk * 64 + hi * 8 + (size_t)(tok0 + q * kstr) * pitch;
    const bf16_t* vp = P.V + hk * 64 + (lane & 7) * 8 + (size_t)(tok0 + (lane >> 3) * kstr) * pitch;
    const size_t tstepb = (size_t)tstep * pitch, vpiece = (size_t)8 * kstr * pitch;
    const int vwoff = ((lane & 7) >> 2) * 2048 + (lane >> 3) * 64 + (lane & 3) * 16;
    const ALAS unsigned char* vb = wl + (4 * hi + ((lane & 15) >> 2)) * 64 + ((lane >> 4) & 1) * 32 + (lane & 3) * 8;
    bf16x8 kn[4], vn[4];
#pragma unroll
    for (int ks = 0; ks < 4; ++ks) kn[ks] = *(const bf16x8*)(kp + 16 * ks);
#pragma unroll
    for (int i = 0; i < 4; ++i) vn[i] = *(const bf16x8*)(vp + i * vpiece);
    f32x16 o0 = {}, o1 = {};
    float mrun = -1e30f, l = 0.f;
    for (int t = 0; t < nt; ++t) {
        bf16x8 kc[4], vc[4];
#pragma unroll
        for (int i = 0; i < 4; ++i) { kc[i] = kn[i]; vc[i] = vn[i]; }
        if (t + 1 < nt) {
            kp += tstepb; vp += tstepb;
#pragma unroll
            for (int ks = 0; ks < 4; ++ks) kn[ks] = *(const bf16x8*)(kp + 16 * ks);
#pragma unroll
            for (int i = 0; i < 4; ++i) vn[i] = *(const bf16x8*)(vp + i * vpiece);
        }
#pragma unroll
        for (int i = 0; i < 4; ++i) *(ALAS bf16x8*)(wl + vwoff + i * 512) = vc[i];
        f32x16 p = {};
#pragma unroll
        for (int ks = 0; ks < 4; ++ks) p = __builtin_amdgcn_mfma_f32_32x32x16_bf16(kc[ks], qf[ks], p, 0, 0, 0);
        const float NEG = -__builtin_inff();
        if (MODE == 0) {
            const int jt = jt0 + t;
            if (jt == 0) {
#pragma unroll
                for (int r = 0; r < 16; ++r) if (crow(r, hi) < q) p[r] = NEG;
            }
            if (jt == 4) {
#pragma unroll
                for (int r = 0; r < 16; ++r) if (crow(r, hi) > q) p[r] = NEG;
            }
        } else if (MODE == 1) {
            const int kr = jt0 + t, rsq = clampi(rq - 4, 0, 24), csq = clampi(cq - 8, 0, 48);
            const bool row_ok = (kr >= rsq) && (kr < rsq + 8);
            const int bidx = (kr - rq + 7) * 31 + (kstart - cq + 15);
#pragma unroll
            for (int r = 0; r < 16; ++r) {
                const int kc_ = kstart + crow(r, hi);
                const bool ok = row_ok && (kc_ >= csq) && (kc_ < csq + 16);
                const float bias = tab[ok ? bidx + crow(r, hi) : 0];
                p[r] = ok ? p[r] + bias : NEG;
            }
        }
        float mx = p[0];
#pragma unroll
        for (int r = 1; r < 16; ++r) mx = fmaxf(mx, p[r]);
        mx = fmaxf(mx, __shfl_xor(mx, 32));
        const float mn = fmaxf(mrun, mx);
        const float alpha = __builtin_amdgcn_exp2f(mrun - mn);
        mrun = mn;
        float rs = 0.f;
#pragma unroll
        for (int r = 0; r < 16; ++r) { p[r] = __builtin_amdgcn_exp2f(p[r] - mn); rs += p[r]; }
        l = l * alpha + rs;
#pragma unroll
        for (int r = 0; r < 16; ++r) { o0[r] *= alpha; o1[r] *= alpha; }
        u32x4 w0, w1;
        w0.x = cvtpk(p[0], p[1]); w0.y = cvtpk(p[2], p[3]); w0.z = cvtpk(p[4], p[5]); w0.w = cvtpk(p[6], p[7]);
        w1.x = cvtpk(p[8], p[9]); w1.y = cvtpk(p[10], p[11]); w1.z = cvtpk(p[12], p[13]); w1.w = cvtpk(p[14], p[15]);
        const bf16x8 pf0 = __builtin_bit_cast(bf16x8, w0), pf1 = __builtin_bit_cast(bf16x8, w1);
#define ATT_VF(off) ({ const s16x4 lo_ = vtr(vb + (off)), hi_ = vtr(vb + (off) + 512); (bf16x8){lo_[0], lo_[1], lo_[2], lo_[3], hi_[0], hi_[1], hi_[2], hi_[3]}; })
        { const bf16x8 v00 = ATT_VF(0), v01 = ATT_VF(1024), v10 = ATT_VF(2048), v11 = ATT_VF(2048 + 1024);
          o0 = __builtin_amdgcn_mfma_f32_32x32x16_bf16(v00, pf0, o0, 0, 0, 0);
          o1 = __builtin_amdgcn_mfma_f32_32x32x16_bf16(v10, pf0, o1, 0, 0, 0);
          o0 = __builtin_amdgcn_mfma_f32_32x32x16_bf16(v01, pf1, o0, 0, 0, 0);
          o1 = __builtin_amdgcn_mfma_f32_32x32x16_bf16(v11, pf1, o1, 0, 0, 0); }
#undef ATT_VF
    }
    l += __shfl_xor(l, 32);
    const float inv = 1.0f / l;
    float wc_ = inv, wp_ = 0.f;
    if (MODE == 0) {
        float lse_new = mrun + __builtin_amdgcn_logf(l);
        if (P.g > 0) {
            const float lp = P.lse[(size_t)qtok * 16 + h];
            const float mm = fmaxf(lp, lse_new), ep = __builtin_amdgcn_exp2f(lp - mm), ec = __builtin_amdgcn_exp2f(lse_new - mm), den = ep + ec;
            wp_ = ep / den; wc_ = inv * (ec / den); lse_new = mm + __builtin_amdgcn_logf(den);
        }
        if (P.g < 2 && hi == 0) P.lse[(size_t)qtok * 16 + h] = lse_new;
    }
    bf16_t* op = P.O + (size_t)qtok * 1024 + h * 64 + 4 * hi;
#pragma unroll
    for (int db = 0; db < 2; ++db)
#pragma unroll
        for (int rr = 0; rr < 4; ++rr) {
            float v[4];
#pragma unroll
            for (int e = 0; e < 4; ++e) v[e] = (db == 0 ? o0[4 * rr + e] : o1[4 * rr + e]) * wc_;
            u32x2* dst = (u32x2*)(op + 32 * db + 8 * rr);
            if (MODE == 0 && P.g > 0) {
                const u32x2 pv = *dst;
                v[0] += wp_ * __uint_as_float(pv.x << 16); v[1] += wp_ * __uint_as_float(pv.x & 0xffff0000u);
                v[2] += wp_ * __uint_as_float(pv.y << 16); v[3] += wp_ * __uint_as_float(pv.y & 0xffff0000u);
            }
            u32x2 w; w.x = cvtpk(v[0], v[1]); w.y = cvtpk(v[2], v[3]);
            *dst = w;
        }
}
template <int MODE>
__device__ __forceinline__ void attn_phase(const AttnP& P, ALAS unsigned char* lds, int vcu, int wave, int lane) {
    ALAS unsigned char* wl = lds + wave * WAVE_LDS;
    for (int k = 0; k < 4; ++k) {
        int u;
        if (MODE == 2) { const int grp = vcu >> 3, j = vcu & 7, b = grp >> 2, kvh = grp & 3, h = kvh * 4 + (j >> 1), qblk = (j & 1) * 32 + k * 8 + wave; u = ((b * 16 + h) << 6) | qblk; }
        else u = vcu * 32 + k * 8 + wave;
        attn_unit<MODE>(P, u, wl, lane);
    }
}
}

namespace atta {
typedef short bf16x8 __attribute__((ext_vector_type(8)));
typedef short s16x4 __attribute__((ext_vector_type(4)));
typedef float f32x16 __attribute__((ext_vector_type(16)));
typedef unsigned u32x4 __attribute__((ext_vector_type(4)));
typedef unsigned u32x2 __attribute__((ext_vector_type(2)));
typedef unsigned short bf16_t;
constexpr int K_OFF = 0, V_OFF = 49152, ST_OFF = 98304, ST_ROW = 144, ST_WAVE = 32 * ST_ROW + 128, LDS_NEED = ST_OFF + 8 * ST_WAVE;
struct Params { const bf16_t* qkv; bf16_t* O; float* lse; int dlog; int g; };
using att::crow; using att::cvtpk; using att::vtr;

__device__ __forceinline__ void phase(const Params& P, ALAS unsigned char* lds, int vcu, int lane_) {
    int tid_ = threadIdx.x; asm volatile("" : "+v"(tid_));
    const int lane = tid_ & 63, w = __builtin_amdgcn_readfirstlane(tid_ >> 6), q = lane & 31, hi = lane >> 5;
    (void)lane_;
    const int dlog = P.dlog, L = 2048 >> dlog, g = P.g;
    const int npieces = (dlog == 4) ? 8 : 12;
    ALAS unsigned char* stg = lds + ST_OFF + w * ST_WAVE;
    ALAS float* stw = (ALAS float*)(stg + 32 * ST_ROW);
    bf16x8 qf[4]; u32x4 prevo[4]; float lprev = 0.f;
#define ATTA_DECODE(k) \
    const int u_ = vcu * 4 + (k), su = u_ & 7, h = (u_ >> 3) & 15, b = u_ >> 7; \
    const int rres = (dlog == 0) ? 0 : (dlog == 2 ? (su >> 1) : 2 * su + (w >> 2)); \
    const int I0 = (dlog == 0) ? 256 * su : (dlog == 2 ? 256 * (su & 1) : 0); \
    const int i0 = (dlog == 4) ? 32 * (w & 3) : I0 + 32 * w; \
    const int tb = (dlog == 4) ? 4 * (w >> 2) + (w & 3) - 2 : w;
#define ATTA_ISSUE(k) do { ATTA_DECODE(k) \
        for (int i = 0; i < npieces; ++i) { const int p = w + 8 * i, T = p >> 3, sub = p & 7; \
            const int res = (dlog == 0) ? 0 : (dlog == 2 ? (su >> 1) : 2 * su + (T >> 2)); \
            const int key0 = (dlog == 4) ? 32 * (T & 3) : I0 - 64 + 32 * T; \
            if (key0 >= 0 && key0 < L) { \
                if (sub < 4) { const int keyl = 8 * sub + (lane >> 3), cp = lane & 7; \
                    const bf16_t* src = P.qkv + (size_t)(b * 2048 + ((key0 + keyl) << dlog) + res) * 3072 + 1024 + h * 64 + ((cp ^ (keyl & 7)) * 8); \
                    __builtin_amdgcn_global_load_lds((const unsigned*)src, (ALAS unsigned*)(lds + K_OFF + T * 4096 + sub * 1024), 16, 0, 0); } \
                else { const int s2 = sub - 4, dh = s2 >> 1, kh = s2 & 1, keyl = 16 * kh + (lane >> 2), c4 = lane & 3; \
                    const bf16_t* src = P.qkv + (size_t)(b * 2048 + ((key0 + keyl) << dlog) + res) * 3072 + 2048 + h * 64 + dh * 32 + c4 * 8; \
                    __builtin_amdgcn_global_load_lds((const unsigned*)src, (ALAS unsigned*)(lds + V_OFF + T * 4096 + dh * 2048 + kh * 1024), 16, 0, 0); } } } \
        { const bf16_t* qp = P.qkv + (size_t)(b * 2048 + ((i0 + q) << dlog) + rres) * 3072 + h * 64 + hi * 8; \
          _Pragma("unroll") for (int ks = 0; ks < 4; ++ks) qf[ks] = *(const bf16x8*)(qp + 16 * ks); } \
        if (g > 0) { \
          _Pragma("unroll") for (int i = 0; i < 4; ++i) { const int row = 8 * i + (lane >> 3); \
              prevo[i] = *(const u32x4*)(P.O + (size_t)(b * 2048 + ((i0 + row) << dlog) + rres) * 1024 + h * 64 + (lane & 7) * 8); } \
          lprev = P.lse[(size_t)(b * 2048 + ((i0 + q) << dlog) + rres) * 16 + h]; } \
    } while (0)

    ATTA_ISSUE(0);
    for (int k = 0; k < 4; ++k) {
        asm volatile("s_waitcnt vmcnt(0)" ::: "memory"); __builtin_amdgcn_s_barrier(); asm volatile("" ::: "memory");
        ATTA_DECODE(k)
        f32x16 p[5];
        const float NEG = -__builtin_inff();
#pragma unroll
        for (int jt = 0; jt < 5; ++jt) {
            const int key0 = i0 - 64 + 32 * jt;
            if (key0 >= 0 && key0 < L) {
                const ALAS unsigned char* kt = lds + K_OFF + (tb + jt) * 4096 + q * 128;
                f32x16 acc = {};
#pragma unroll
                for (int ks = 0; ks < 4; ++ks) { const bf16x8 kf = *(const ALAS bf16x8*)(kt + (((2 * ks + hi) ^ (q & 7)) * 16)); acc = __builtin_amdgcn_mfma_f32_32x32x16_bf16(kf, qf[ks], acc, 0, 0, 0); }
                if (jt == 0) {
#pragma unroll
                    for (int r = 0; r < 16; ++r) if (crow(r, hi) < q) acc[r] = NEG;
                }
                if (jt == 4) {
#pragma unroll
                    for (int r = 0; r < 16; ++r) if (crow(r, hi) > q) acc[r] = NEG;
                }
                p[jt] = acc;
            } else {
#pragma unroll
                for (int r = 0; r < 16; ++r) p[jt][r] = NEG;
            }
        }
        float mx = p[2][0];
#pragma unroll
        for (int jt = 0; jt < 5; ++jt)
#pragma unroll
            for (int r = 0; r < 16; ++r) mx = fmaxf(mx, p[jt][r]);
        mx = fmaxf(mx, __shfl_xor(mx, 32));
        float l = 0.f;
#pragma unroll
        for (int jt = 0; jt < 5; ++jt)
#pragma unroll
            for (int r = 0; r < 16; ++r) { p[jt][r] = __builtin_amdgcn_exp2f(p[jt][r] - mx); l += p[jt][r]; }
        l += __shfl_xor(l, 32);
        f32x16 o0 = {}, o1 = {};
        const ALAS unsigned char* vb = lds + V_OFF + (4 * hi + ((lane & 15) >> 2)) * 64 + ((lane >> 4) & 1) * 32 + (lane & 3) * 8;
#pragma unroll
        for (int jt = 0; jt < 5; ++jt) {
            const int key0 = i0 - 64 + 32 * jt;
            if (key0 >= 0 && key0 < L) {
                const ALAS unsigned char* vt = vb + (tb + jt) * 4096;
                u32x4 w0, w1;
                w0.x = cvtpk(p[jt][0], p[jt][1]); w0.y = cvtpk(p[jt][2], p[jt][3]); w0.z = cvtpk(p[jt][4], p[jt][5]); w0.w = cvtpk(p[jt][6], p[jt][7]);
                w1.x = cvtpk(p[jt][8], p[jt][9]); w1.y = cvtpk(p[jt][10], p[jt][11]); w1.z = cvtpk(p[jt][12], p[jt][13]); w1.w = cvtpk(p[jt][14], p[jt][15]);
                const bf16x8 pf0 = __builtin_bit_cast(bf16x8, w0), pf1 = __builtin_bit_cast(bf16x8, w1);
#define ATTA_VF(off) ({ const s16x4 lo_ = vtr(vt + (off)), hi_ = vtr(vt + (off) + 512); (bf16x8){lo_[0], lo_[1], lo_[2], lo_[3], hi_[0], hi_[1], hi_[2], hi_[3]}; })
                const bf16x8 v00 = ATTA_VF(0), v01 = ATTA_VF(1024), v10 = ATTA_VF(2048), v11 = ATTA_VF(2048 + 1024);
#undef ATTA_VF
                o0 = __builtin_amdgcn_mfma_f32_32x32x16_bf16(v00, pf0, o0, 0, 0, 0);
                o1 = __builtin_amdgcn_mfma_f32_32x32x16_bf16(v10, pf0, o1, 0, 0, 0);
                o0 = __builtin_amdgcn_mfma_f32_32x32x16_bf16(v01, pf1, o0, 0, 0, 0);
                o1 = __builtin_amdgcn_mfma_f32_32x32x16_bf16(v11, pf1, o1, 0, 0, 0);
            }
        }
        const float inv = 1.0f / l;
        float wc_ = inv, wp_ = 0.f, lse_new = mx + __builtin_amdgcn_logf(l);
        if (g > 0) {
            const float mm = fmaxf(lprev, lse_new), ep = __builtin_amdgcn_exp2f(lprev - mm), ec = __builtin_amdgcn_exp2f(lse_new - mm), den = ep + ec;
            wp_ = ep / den; wc_ = inv * (ec / den); lse_new = mm + __builtin_amdgcn_logf(den);
        }
        if (g < 2 && hi == 0) P.lse[(size_t)(b * 2048 + ((i0 + q) << dlog) + rres) * 16 + h] = lse_new;
#pragma unroll
        for (int db = 0; db < 2; ++db)
#pragma unroll
            for (int rr = 0; rr < 4; ++rr) {
                u32x2 wv;
                wv.x = cvtpk((db == 0 ? o0[4 * rr + 0] : o1[4 * rr + 0]) * wc_, (db == 0 ? o0[4 * rr + 1] : o1[4 * rr + 1]) * wc_);
                wv.y = cvtpk((db == 0 ? o0[4 * rr + 2] : o1[4 * rr + 2]) * wc_, (db == 0 ? o0[4 * rr + 3] : o1[4 * rr + 3]) * wc_);
                *(ALAS u32x2*)(stg + q * ST_ROW + (32 * db + 8 * rr + 4 * hi) * 2) = wv;
            }
        if (hi == 0) stw[q] = wp_;
        u32x4 pv[4];
#pragma unroll
        for (int i = 0; i < 4; ++i) pv[i] = prevo[i];
        bf16_t* const obase = P.O + (size_t)(b * 2048 + rres) * 1024 + h * 64 + (lane & 7) * 8;
        const int orow0 = i0 + (lane >> 3);
        asm volatile("s_waitcnt lgkmcnt(0)" ::: "memory"); __builtin_amdgcn_s_barrier(); asm volatile("" ::: "memory");
        if (k + 1 < 4) ATTA_ISSUE(k + 1);
#pragma unroll
        for (int i = 0; i < 4; ++i) {
            const int row = 8 * i + (lane >> 3);
            const u32x4 sv = *(const ALAS u32x4*)(stg + row * ST_ROW + (lane & 7) * 16);
            u32x4 ov = sv;
            if (g > 0) {
                const float wr_ = stw[row];
#pragma unroll
                for (int e = 0; e < 4; ++e) {
                    const float a0 = __uint_as_float(sv[e] << 16) + wr_ * __uint_as_float(pv[i][e] << 16);
                    const float a1 = __uint_as_float(sv[e] & 0xffff0000u) + wr_ * __uint_as_float(pv[i][e] & 0xffff0000u);
                    ov[e] = cvtpk(a0, a1);
                }
            }
            *(u32x4*)(obase + ((size_t)((orow0 + 8 * i) << dlog)) * 1024) = ov;
        }
    }
    asm volatile("s_waitcnt vmcnt(0) lgkmcnt(0)" ::: "memory"); __builtin_amdgcn_s_barrier(); asm volatile("" ::: "memory");
#undef ATTA_DECODE
#undef ATTA_ISSUE
}
}

constexpr int NWAVES = 8;
#ifndef MK_N_LAUNCHES
#define MK_N_LAUNCHES 1
#endif
constexpr int N_PHASES = 30;
constexpr int N_LAUNCHES = MK_N_LAUNCHES;
constexpr int BATCH = 8, SEQ = 2048, D = 1024, FF = 4096, M = BATCH * SEQ;
constexpr size_t MiB = 1u << 20;
constexpr size_t WS_CTL = 0, CTL_ZERO_BYTES = 1 * MiB;
constexpr size_t WS_TAB = 1 * MiB;
constexpr size_t WS_RSS = 2 * MiB;
constexpr size_t WS_LSE = 3 * MiB;
constexpr size_t WS_XB = 121 * MiB;
constexpr size_t WS_ACT = 153 * MiB, WS_QKV = WS_ACT, WS_O = 249 * MiB, WS_H = WS_ACT, WS_END = 281 * MiB;
constexpr int CW_BAR = 4096;
constexpr int RING_OFF = 0, RING_BYTES = 131072;
constexpr int LDSCTL_OFF = 139264, MISC_OFF = LDSCTL_OFF + 320;
constexpr int TB_OFF = LDSCTL_OFF + 1024;
constexpr int LDS_BYTES = 147456;

struct Args { const float* in[29]; float* out; unsigned char* ws; int ph_lo, ph_hi; };
struct LayerDesc { const float *anorm, *win, *wout, *mnorm, *wup, *wdown, *rpb, *qn, *kn; int kind, nin; size_t o_in, o_out, o_up, o_down; };
__device__ __forceinline__ LayerDesc get_layer(const Args& a, int L) {
    LayerDesc d; int base, wo;
    if (L == 0)      { base = 1;  wo = 3;  d.kind = 0; d.nin = 9216; d.o_in = 4 * MiB;  d.o_out = 22 * MiB;  d.o_up = 24 * MiB;  d.o_down = 32 * MiB; }
    else if (L == 1) { base = 7;  wo = 10; d.kind = 1; d.nin = 3072; d.o_in = 40 * MiB; d.o_out = 46 * MiB;  d.o_up = 48 * MiB;  d.o_down = 56 * MiB; }
    else if (L == 2) { base = 14; wo = 18; d.kind = 2; d.nin = 1536; d.o_in = 64 * MiB; d.o_out = 67 * MiB;  d.o_up = 69 * MiB;  d.o_down = 77 * MiB; }
    else             { base = 22; wo = 24; d.kind = 0; d.nin = 9216; d.o_in = 85 * MiB; d.o_out = 103 * MiB; d.o_up = 105 * MiB; d.o_down = 113 * MiB; }
    d.anorm = a.in[base]; d.win = a.in[base + 1]; d.wout = a.in[wo]; d.mnorm = a.in[wo + 1]; d.wup = a.in[wo + 2]; d.wdown = a.in[wo + 3];
    d.rpb = a.in[9]; d.qn = a.in[16]; d.kn = a.in[17];
    return d;
}

__device__ __forceinline__ float wave_sum(float v) {
#pragma unroll
    for (int o = 1; o < 64; o <<= 1) v += __shfl_xor(v, o);
    return v;
}
__device__ __forceinline__ void titem_load(const float* W, int N, const float* gain, int nblk, int item, int lane, f32x4 (&v)[8], float (&gk)[8]) {
    const int kb = item / nblk, nb = item - kb * nblk, k0 = 64 * kb, n0 = 32 * nb;
#pragma unroll
    for (int i = 0; i < 8; ++i) { const int kk = 8 * i + (lane >> 3), n4 = 4 * (lane & 7);
        v[i] = *(const GAS f32x4*)(W + (size_t)(k0 + kk) * N + n0 + n4); gk[i] = gain ? gain[k0 + kk] : 1.0f; }
}
__device__ __forceinline__ void titem_store(const f32x4 (&v)[8], const float (&gk)[8], int K, bf16* WT, bool perm, LAS float* scr, int nblk, int item, int lane) {
    const int kb = item / nblk, nb = item - kb * nblk, k0 = 64 * kb, n0 = 32 * nb;
#pragma unroll
    for (int i = 0; i < 8; ++i) { const int kk = 8 * i + (lane >> 3), n4 = 4 * (lane & 7);
        LAS float* s = scr + kk * 33 + n4; s[0] = v[i][0] * gk[i]; s[1] = v[i][1] * gk[i]; s[2] = v[i][2] * gk[i]; s[3] = v[i][3] * gk[i]; }
    LDS_WAIT(); asm volatile("" ::: "memory");
    const int c = lane & 7;
    const int nrow0 = perm ? ((n0 & ~255) | (((n0 >> 5) & 1) << 7) | (((n0 >> 6) & 3) << 5)) : n0;
#pragma unroll
    for (int j = 0; j < 4; ++j) { const int n = (lane >> 3) + 8 * j; const LAS float* s = scr + (8 * c) * 33 + n;
        v4u o; o.x = pk2(s[0 * 33], s[1 * 33]); o.y = pk2(s[2 * 33], s[3 * 33]); o.z = pk2(s[4 * 33], s[5 * 33]); o.w = pk2(s[6 * 33], s[7 * 33]);
        *(GAS v4u*)(WT + (size_t)(nrow0 + n) * K + k0 + 8 * c) = o; }
    LDS_WAIT(); asm volatile("" ::: "memory");
}
__global__ void __launch_bounds__(NWAVES * 64, 2) mk_fwd(Args args) {
    extern __shared__ __attribute__((aligned(16))) unsigned char lds[];
    LAS unsigned char* const L3 = (LAS unsigned char*)lds;
    volatile LAS unsigned* const MISC = (volatile LAS unsigned*)(L3 + MISC_OFF);
    const int tid = threadIdx.x, lane = tid & 63, wave = __builtin_amdgcn_readfirstlane(tid >> 6);
    const int G = gridDim.x; const int bx = blockIdx.x; const int vcu = (G % 8 == 0) ? (bx % 8) * (G / 8) + bx / 8 : bx;
    unsigned char* const ws = args.ws;
    gu32* const ctl = (gu32*)(ws + WS_CTL);
    for (int u = tid; u < (LDS_BYTES - LDSCTL_OFF) / 4; u += NWAVES * 64) ((LAS unsigned*)(L3 + LDSCTL_OFF))[u] = 0u;
    __syncthreads();
    XcdBarrier bar; bar.bar = (unsigned*)(ctl + CW_BAR); bar.x = 0; bar.st = nullptr;
    if (N_LAUNCHES == 1) bar = xcd_barrier_post((unsigned*)(ctl + CW_BAR), MISC + 8);
    const int lo = args.ph_lo, hi = args.ph_hi;
    int ph = 0;
#ifndef PROBE_DUP_MASK
#define PROBE_DUP_MASK 0ull
#endif
#define PH_ON() (lo <= ph && ph < hi)
#ifndef PROBE_REPS
#define PROBE_REPS 2
#endif
#define PH_REP() (((PROBE_DUP_MASK >> ph) & 1ull) ? PROBE_REPS : 1)
#define PH_END() do { if (ph + 1 < hi) { if (N_LAUNCHES == 1) xcd_barrier(bar); } ++ph; } while (0)

#define tabs ((float*)(ws + WS_TAB))
#define invA (tabs)
#define invC (tabs + 32)
#define rss ((float*)(ws + WS_RSS))
#define lse ((float*)(ws + WS_LSE))
#define XB ((bf16*)(ws + WS_XB))
#define QKV ((bf16*)(ws + WS_QKV))
#define OB ((bf16*)(ws + WS_O))
#define HB ((bf16*)(ws + WS_H))
    const int gw = vcu * NWAVES + wave, NGW = G * NWAVES;

    if (PH_ON()) for (int rep_ = 0; rep_ < PH_REP(); ++rep_) {
        LAS float* scr = (LAS float*)(L3 + RING_OFF + wave * 16384);
        int rot = 0;
        for (int mi = 0; mi < 16; ++mi) {
            const LayerDesc d = get_layer(args, mi >> 2); const int j = mi & 3;
            const float* W = j == 0 ? d.win : j == 1 ? d.wout : j == 2 ? d.wup : d.wdown;
            const int K = j == 3 ? FF : D, N = j == 0 ? d.nin : j == 2 ? FF : D;
            const float* gain = j == 0 ? d.anorm : j == 2 ? d.mnorm : nullptr;
            bf16* WT = (bf16*)(ws + (j == 0 ? d.o_in : j == 1 ? d.o_out : j == 2 ? d.o_up : d.o_down));
            const int nitems = (K / 64) * (N / 32);
            int it0 = (gw - rot) % NGW; if (it0 < 0) it0 += NGW;
            const int nblk = N / 32;
            f32x4 cv[8], nv[8]; float cg[8], ng[8];
            int it = it0;
            if (it < nitems) titem_load(W, N, gain, nblk, it, lane, cv, cg);
            while (it < nitems) {
                const int nx = it + NGW;
                if (nx < nitems) titem_load(W, N, gain, nblk, nx, lane, nv, ng);
                titem_store(cv, cg, K, WT, j == 0, scr, nblk, it, lane);
#pragma unroll
                for (int i = 0; i < 8; ++i) { cv[i] = nv[i]; cg[i] = ng[i]; }
                it = nx;
            }
            rot = (rot + nitems) % NGW;
        }
        const float* x = args.in[0];
        { f32x4 v[4], vn[4];
          if (gw < M) { const GAS f32x4* xr = (const GAS f32x4*)(x + (size_t)gw * D) + lane;
#pragma unroll
              for (int j = 0; j < 4; ++j) v[j] = xr[64 * j]; }
          for (int m = gw; m < M; m += NGW) {
            if (m + NGW < M) { const GAS f32x4* xr = (const GAS f32x4*)(x + (size_t)(m + NGW) * D) + lane;
#pragma unroll
                for (int j = 0; j < 4; ++j) vn[j] = xr[64 * j]; }
            float s = 0.f;
            GAS unsigned long long* o8 = (GAS unsigned long long*)(XB + (size_t)m * D) + lane;
#pragma unroll
            for (int j = 0; j < 4; ++j) { const unsigned lo = pk2(v[j].x, v[j].y), hi2 = pk2(v[j].z, v[j].w); o8[64 * j] = (unsigned long long)lo | ((unsigned long long)hi2 << 32);
                const float r0 = __uint_as_float(lo << 16), r1 = __uint_as_float(lo & 0xffff0000u), r2 = __uint_as_float(hi2 << 16), r3 = __uint_as_float(hi2 & 0xffff0000u);
                s += (r0 * r0 + r1 * r1) + (r2 * r2 + r3 * r3); }
            s = wave_sum(s);
            if (lane < 4) rss[(size_t)m * 4 + lane] = (lane == 0) ? s : 0.f;
#pragma unroll
            for (int j = 0; j < 4; ++j) v[j] = vn[j];
          } }
        if (bx == 0 && tid < 64) {
            const int i = tid & 31;
            if (tid < 32) invA[i] = 1.0f / powf(10000.0f, (float)(2 * i) / 64.0f);
            else invC[i] = 1.0f / powf(10000.0f, (float)(2 * (i & 15)) / 32.0f);
        }
    }
    PH_END();

    for (int L = 0; L < 4; ++L) {
        const int kind = (L == 1) ? 1 : (L == 2) ? 2 : 0;
#define LD() const LayerDesc d = get_layer(args, L)
        if (kind == 0) {
            for (int g = 0; g < 3; ++g) {
                if (PH_ON()) for (int rep_ = 0; rep_ < PH_REP(); ++rep_) {
                    LD(); pg8::Gemm gm{XB, (const bf16*)(ws + d.o_in) + (size_t)g * 3072 * D, M, 3072, D}; pg8::StaticOrder S; S.init(M, 3072, G, bx);
                    pg8::fill_tables((LAS float*)(L3 + TB_OFF), S, rss, invA, nullptr, nullptr);
                    pg8::EpiQKV<0> E{QKV, 3072, (const LAS float*)(L3 + TB_OFF)};
                    pg8::gemm_phase<pg8::EpiQKV<0>, pg8::StaticOrder, true, true>(L3 + RING_OFF, gm, S, E);
                }
                PH_END();
                if (PH_ON()) for (int rep_ = 0; rep_ < PH_REP(); ++rep_) {
                    atta::Params P{QKV, OB, lse, g == 0 ? 0 : (g == 1 ? 2 : 4), g};
                    atta::phase(P, L3 + RING_OFF, vcu, lane);
                }
                PH_END();
            }
        } else if (kind == 1) {
            if (PH_ON()) for (int rep_ = 0; rep_ < PH_REP(); ++rep_) {
                LD(); pg8::Gemm gm{XB, (const bf16*)(ws + d.o_in), M, 3072, D}; pg8::StaticOrder S; S.init(M, 3072, G, bx);
                pg8::fill_tables((LAS float*)(L3 + TB_OFF), S, rss, nullptr, nullptr, nullptr);
                pg8::EpiQKV<1> E{QKV, 3072, (const LAS float*)(L3 + TB_OFF)};
                pg8::gemm_phase<pg8::EpiQKV<1>, pg8::StaticOrder, true, true>(L3 + RING_OFF, gm, S, E);
            }
            PH_END();
            if (PH_ON()) for (int rep_ = 0; rep_ < PH_REP(); ++rep_) {
                att::AttnP P{QKV, QKV + 1024, QKV + 2048, 3072, OB, lse, args.in[9], 0, 0};
                att::attn_phase<1>(P, L3 + RING_OFF, vcu, wave, lane);
            }
            PH_END();
        } else {
            if (PH_ON()) for (int rep_ = 0; rep_ < PH_REP(); ++rep_) {
                LD(); pg8::Gemm gm{XB, (const bf16*)(ws + d.o_in), M, 1536, D}; pg8::StaticOrder S; S.init(M, 1536, G, bx);
                pg8::fill_tables((LAS float*)(L3 + TB_OFF), S, rss, invC, args.in[16], args.in[17]);
                pg8::EpiQKV<2> E{QKV, 1536, (const LAS float*)(L3 + TB_OFF)};
                pg8::gemm_phase<pg8::EpiQKV<2>, pg8::StaticOrder, true, true>(L3 + RING_OFF, gm, S, E);
            }
            PH_END();
            if (PH_ON()) for (int rep_ = 0; rep_ < PH_REP(); ++rep_) {
                const attc::AttnTensors AT{(const attc::bf16*)QKV, (const attc::bf16*)(QKV + 1024), (const attc::bf16*)(QKV + 1280), (attc::bf16*)OB};
                attc::attn_phase<8>((char*)lds + RING_OFF, AT, vcu);
            }
            PH_END();
        }
        if (PH_ON()) for (int rep_ = 0; rep_ < PH_REP(); ++rep_) {
            LD(); pg8::Gemm gm{OB, (const bf16*)(ws + d.o_out), M, D, D}; pg8::StaticOrder S; S.init(M, D, G, bx);
            pg8::EpiRes E{XB, rss};
            pg8::gemm_phase<pg8::EpiRes, pg8::StaticOrder, false, true>(L3 + RING_OFF, gm, S, E);
        }
        PH_END();
        if (PH_ON()) for (int rep_ = 0; rep_ < PH_REP(); ++rep_) {
            LD(); pg8::Gemm gm{XB, (const bf16*)(ws + d.o_up), M, FF, D}; pg8::StaticOrder S; S.init(M, FF, G, bx);
            pg8::fill_tables((LAS float*)(L3 + TB_OFF), S, rss, nullptr, nullptr, nullptr);
            pg8::EpiUp E{HB, FF, (const LAS float*)(L3 + TB_OFF)};
            pg8::gemm_phase<pg8::EpiUp, pg8::StaticOrder, true, true>(L3 + RING_OFF, gm, S, E);
        }
        PH_END();
        if (PH_ON()) for (int rep_ = 0; rep_ < PH_REP(); ++rep_) {
            LD(); pg8::Gemm gm{HB, (const bf16*)(ws + d.o_down), M, D, FF}; pg8::StaticOrder S; S.init(M, D, G, bx);
            pg8::EpiRes E{XB, rss};
            pg8::gemm_phase<pg8::EpiRes, pg8::StaticOrder, false, true>(L3 + RING_OFF, gm, S, E);
        }
        PH_END();
    }
    if (PH_ON()) for (int rep_ = 0; rep_ < PH_REP(); ++rep_) {
        const float* gf = args.in[28];
        for (int m = gw; m < M; m += NGW) {
            const float rstd = pg8::row_rstd(rss, m);
            const GAS unsigned long long* xr = (const GAS unsigned long long*)(XB + (size_t)m * D) + lane; GAS f32x4* orow = (GAS f32x4*)(args.out + (size_t)m * D) + lane; const GAS f32x4* gr = (const GAS f32x4*)gf + lane;
#pragma unroll
            for (int j = 0; j < 4; ++j) { const unsigned long long xv = xr[64 * j]; const unsigned lo = (unsigned)xv, hi2 = (unsigned)(xv >> 32); const f32x4 gg = gr[64 * j];
                f32x4 v; v.x = __uint_as_float(lo << 16); v.y = __uint_as_float(lo & 0xffff0000u); v.z = __uint_as_float(hi2 << 16); v.w = __uint_as_float(hi2 & 0xffff0000u);
                orow[64 * j] = v * rstd * gg; }
        }
    }
#undef PH_ON
#undef PH_END
#undef LD
}

extern "C" void kernel_launch(void* const* d_in, const int* in_sizes, int n_in, void* d_out, int out_size, void* d_ws, size_t ws_size, hipStream_t stream) {
    static int grid = 0;
    if (grid == 0) {
        if (n_in != 29 || in_sizes[0] != M * D || out_size != M * D || ws_size < WS_END) { fprintf(stderr, "kernel_launch: unexpected shapes / workspace (n_in %d, ws %zu); nothing launched\n", n_in, ws_size); grid = -1; return; }
        int dev = 0, cus = 0, per_cu = 0;
        if (hipGetDevice(&dev) != hipSuccess || hipDeviceGetAttribute(&cus, hipDeviceAttributeMultiprocessorCount, dev) != hipSuccess) { grid = -1; return; }
        if (hipFuncSetAttribute((const void*)mk_fwd, hipFuncAttributeMaxDynamicSharedMemorySize, LDS_BYTES) != hipSuccess) { fprintf(stderr, "kernel_launch: hipFuncSetAttribute failed\n"); grid = -1; return; }
        if (hipOccupancyMaxActiveBlocksPerMultiprocessor(&per_cu, (const void*)mk_fwd, NWAVES * 64, LDS_BYTES) != hipSuccess || per_cu < 1) fprintf(stderr, "kernel_launch: occupancy query reports %d\n", per_cu);
        (void)hipGetLastError();
        if (cus != 256) { fprintf(stderr, "kernel_launch: built for a 256-CU device, found %d; nothing launched\n", cus); grid = -1; return; }
        grid = 256;
    }
    if (grid < 0) return;
    if (hipMemsetAsync((char*)d_ws + WS_CTL, 0, CTL_ZERO_BYTES, stream) != hipSuccess) return;
    Args a{};
    for (int i = 0; i < 29; ++i) a.in[i] = (const float*)d_in[i];
    a.out = (float*)d_out; a.ws = (unsigned char*)d_ws;
    if (N_LAUNCHES == 1) { a.ph_lo = 0; a.ph_hi = N_PHASES; hipLaunchKernelGGL(mk_fwd, dim3(grid), dim3(NWAVES * 64), LDS_BYTES, stream, a); }
    else for (int p = 0; p < N_PHASES; ++p) { a.ph_lo = p; a.ph_hi = p + 1; hipLaunchKernelGGL(mk_fwd, dim3(grid), dim3(NWAVES * 64), LDS_BYTES, stream, a); }
}
```

```cpp
#include <hip/hip_runtime.h>
#include <cstdio>
#include <cstdint>
namespace pg8 {
#define PG8_LAS __attribute__((address_space(3)))
typedef unsigned short bf16_t;
typedef short bf16x8 __attribute__((ext_vector_type(8)));
typedef float f32x4 __attribute__((ext_vector_type(4)));
typedef unsigned u32x4 __attribute__((ext_vector_type(4)));
constexpr int BM = 256, BK = 64, HALF = 128, HTB = HALF * BK * 2  , STAGE_BYTES = 8 * HTB, NXCD = 8, WGM = 8;

__host__ __device__ __forceinline__ int lds_byte(int r, int c) { const int st = (r >> 4) * 2 + (c >> 5), rr = r & 15, cc = c & 31, ob = rr * 64 + cc * 2; return st * 1024 + (ob ^ (((ob >> 9) & 1) << 5)); }
__host__ __device__ __forceinline__ void stage_rc(int b, int& R, int& C) { const int st = b / 1024, sb = b % 1024, swz = sb ^ (((sb >> 9) & 1) << 5); R = (st >> 1) * 16 + swz / 64; C = (st & 1) * 32 + (swz % 64) / 2; }
__host__ __device__ __forceinline__ int perm32(int rho) { const int n = rho >> 4, i = rho & 15; return 8 * (i >> 2) + 4 * n + (i & 3); }

struct Unit { int pm, pn; };
struct Gemm { const bf16_t* A; const bf16_t* Bt; int M, N, K; };

struct StaticOrder {
    int nM, nN, nwg, G, c;
    __host__ __device__ void init(int M, int N, int G_, int c_) { nM = M / BM; nN = N / BM; nwg = nM * nN; G = G_; c = c_; }
    __host__ __device__ bool next(int i, Unit& u) const {
        const long L = (long)i * G + c; if (L >= nwg) return false;
        int wgid = (int)L; { const int q = nwg / NXCD, r = nwg % NXCD, xcd = wgid % NXCD, off = wgid / NXCD; wgid = (xcd < r ? xcd * (q + 1) : r * (q + 1) + (xcd - r) * q) + off; }
        const int nig = WGM * nN, gid = wgid / nig, fm = gid * WGM, gsz = (nM - fm) < WGM ? (nM - fm) : WGM;
        u.pm = fm + ((wgid % nig) % gsz); u.pn = (wgid % nig) / gsz; return true;
    }
    __device__ __forceinline__ void a_ready(const Unit&) const {}
    __device__ __forceinline__ void done(const Unit&) const {}
};


__device__ __forceinline__ unsigned cvt_pk_bf16(float lo, float hi) { unsigned r; asm volatile("v_cvt_pk_bf16_f32 %0, %1, %2" : "=v"(r) : "v"(lo), "v"(hi)); return r; }
typedef unsigned u32x2 __attribute__((ext_vector_type(2)));
constexpr float QSCALE = 0.125f * 1.4426950408889634f;
constexpr float RMS_EPS = 1e-6f;
__device__ __forceinline__ float rstd_of(const f32x4 p) { return __builtin_amdgcn_rsqf(((p[0] + p[1]) + (p[2] + p[3])) * (1.0f / 1024.0f) + RMS_EPS); }
__device__ __forceinline__ float row_rstd(const float* rss, int row) { return rstd_of(*(const f32x4*)(rss + (size_t)row * 4)); }
__device__ __forceinline__ void sincos_rev(float a, float& s, float& c) {
    const float k = __builtin_rintf(a * 0.15915494309189535f);
    float r = __builtin_fmaf(-k, 6.28318548202514648f, a); r = __builtin_fmaf(-k, -1.7484555e-7f, r);
    const float x = r * 0.15915494309189535f;
    s = __builtin_amdgcn_sinf(x); c = __builtin_amdgcn_cosf(x);
}
template <int KIND> struct EpiQKV {
    static constexpr bool PERM = true, AFTER_DRAIN = false;
    bf16_t* O; int ldc; const PG8_LAS float* tb;
    __device__ __forceinline__ void operator()(const f32x4 (&acc)[2][2][4][2], const Unit& u, int wr, int wc, int fr, int fq, int ui) const {
        const int tcol = u.pn * BM;
        int sec;
        if (KIND == 2) sec = tcol < 1024 ? 0 : (tcol == 1024 ? 1 : 2); else sec = tcol >> 10;
        const int row0 = u.pm * BM + wr * 64 + fr;
        const int lc0 = tcol + 64 * wc + 8 * fq;
        const bool do_rope = (KIND != 1) && sec < 2;
        const bool do_hn = (KIND == 2) && sec < 2;
        const float qs = (sec == 0) ? QSCALE : 1.0f;
        const PG8_LAS float* rt = tb + ui * 256 + wr * 64 + fr;
        f32x4 iv[2] = {(f32x4){0.f, 0.f, 0.f, 0.f}, (f32x4){0.f, 0.f, 0.f, 0.f}};
        if (do_rope) { iv[0] = *(const PG8_LAS f32x4*)(tb + 1024 + 8 * fq); iv[1] = *(const PG8_LAS f32x4*)(tb + 1024 + 8 * fq + 4); }
        f32x4 g[2][2];
#pragma unroll
        for (int bj = 0; bj < 2; ++bj)
#pragma unroll
            for (int n = 0; n < 2; ++n) g[bj][n] = (f32x4){1.f, 1.f, 1.f, 1.f};
        if (do_hn) { const PG8_LAS float* gp = tb + 1056 + (sec == 0 ? 0 : 64);
#pragma unroll
            for (int bj = 0; bj < 2; ++bj)
#pragma unroll
                for (int n = 0; n < 2; ++n) g[bj][n] = *(const PG8_LAS f32x4*)(gp + 32 * bj + 8 * fq + 4 * n); }
#pragma unroll
        for (int ai = 0; ai < 2; ++ai)
#pragma unroll
            for (int m = 0; m < 4; ++m) {
                const int row = row0 + ai * HALF + m * 16;
                const float rstd = rt[ai * HALF + m * 16];
                f32x4 v[2][2];
#pragma unroll
                for (int bj = 0; bj < 2; ++bj)
#pragma unroll
                    for (int n = 0; n < 2; ++n) v[bj][n] = acc[ai][bj][m][n] * rstd;
                if (do_hn) {
                    float ss = 0.f;
#pragma unroll
                    for (int bj = 0; bj < 2; ++bj)
#pragma unroll
                        for (int n = 0; n < 2; ++n) { const f32x4 x = v[bj][n]; ss += (x[0] * x[0] + x[1] * x[1]) + (x[2] * x[2] + x[3] * x[3]); }
                    ss += __shfl_xor(ss, 16); ss += __shfl_xor(ss, 32);
                    const float r2 = __builtin_amdgcn_rsqf(ss * (1.0f / 64.0f) + RMS_EPS);
#pragma unroll
                    for (int bj = 0; bj < 2; ++bj)
#pragma unroll
                        for (int n = 0; n < 2; ++n) v[bj][n] = v[bj][n] * r2 * g[bj][n];
                }
                if (do_rope) {
                    const int t = row & 2047;
                    const float posf = (float)(KIND == 2 ? (fq < 2 ? (t >> 6) : (t & 63)) : t);
#pragma unroll
                    for (int n = 0; n < 2; ++n)
#pragma unroll
                        for (int e = 0; e < 4; ++e) {
                            float s, c; sincos_rev(posf * iv[n][e], s, c);
                            const float x1 = v[0][n][e], x2 = v[1][n][e];
                            v[0][n][e] = x1 * c - x2 * s; v[1][n][e] = x2 * c + x1 * s;
                        }
                }
                bf16_t* rowp = O + (size_t)row * ldc + lc0;
#pragma unroll
                for (int bj = 0; bj < 2; ++bj) {
                    const f32x4 v0 = v[bj][0] * qs, v1 = v[bj][1] * qs;
                    u32x4 w; w.x = cvt_pk_bf16(v0[0], v0[1]); w.y = cvt_pk_bf16(v0[2], v0[3]); w.z = cvt_pk_bf16(v1[0], v1[1]); w.w = cvt_pk_bf16(v1[2], v1[3]);
                    *(u32x4*)(rowp + 32 * bj) = w;
                }
            }
    }
};
struct TablePre {
    PG8_LAS float* tb; int tid; f32x4 p[4]; bool ok[4]; float sv; int sidx;
    template <class Sched> __device__ __forceinline__ void load(PG8_LAS float* tb_, const Sched& S, const float* rss, const float* inv, const float* qg, const float* kg) {
        int tid_ = threadIdx.x; asm volatile("" : "+v"(tid_));
        tb = tb_; tid = tid_; sidx = -1; sv = 0.f;
        Unit u;
#pragma unroll
        for (int i = 0; i < 4; ++i) { ok[i] = false; p[i] = (f32x4){0.f, 0.f, 0.f, 0.f}; }
        if (tid_ < 256) {
#pragma unroll
            for (int i = 0; i < 4; ++i) { ok[i] = S.next(i, u); if (ok[i]) p[i] = *(const f32x4*)(rss + (size_t)(u.pm * BM + tid_) * 4); }
        } else if (tid_ < 288) { if (inv) { sv = inv[tid_ - 256]; sidx = 1024 + tid_ - 256; } }
        else if (tid_ < 352) { if (qg) { sv = qg[tid_ - 288]; sidx = 1056 + tid_ - 288; } }
        else if (tid_ < 416) { if (kg) { sv = kg[tid_ - 352]; sidx = 1120 + tid_ - 352; } }
    }
    __device__ __forceinline__ void operator()() const {
#pragma unroll
        for (int i = 0; i < 4; ++i) if (ok[i]) tb[i * 256 + tid] = rstd_of(p[i]);
        if (sidx >= 0) tb[sidx] = sv;
        asm volatile("s_waitcnt lgkmcnt(0)" ::: "memory"); __builtin_amdgcn_s_barrier(); asm volatile("" ::: "memory");
    }
};
struct EpiRes {
    static constexpr bool PERM = false, AFTER_DRAIN = true;
    bf16_t* xb; float* rss;
    __device__ __forceinline__ void fused(const f32x4 (&acc)[2][2][4][2], const Unit& u, int wr, int wc, int fr, int fq, PG8_LAS unsigned char* lds, int wid, int lane) const {
        const int row0 = u.pm * BM + wr * 64 + fr, col0 = u.pn * BM + wc * 32 + 4 * fq;
        PG8_LAS float* P = (PG8_LAS float*)lds;
        u32x2 xi[2][4][2][2];
#pragma unroll
        for (int ai = 0; ai < 2; ++ai)
#pragma unroll
            for (int m = 0; m < 4; ++m)
#pragma unroll
                for (int bj = 0; bj < 2; ++bj)
#pragma unroll
                    for (int n = 0; n < 2; ++n) xi[ai][m][bj][n] = *(const u32x2*)(xb + (size_t)(row0 + ai * HALF + m * 16) * 1024 + col0 + bj * HALF + n * 16);
#pragma unroll
        for (int ai = 0; ai < 2; ++ai)
#pragma unroll
            for (int m = 0; m < 4; ++m) {
                const int row = row0 + ai * HALF + m * 16; float ss = 0.f;
#pragma unroll
                for (int bj = 0; bj < 2; ++bj)
#pragma unroll
                    for (int n = 0; n < 2; ++n) {
                        const size_t off = (size_t)row * 1024 + col0 + bj * HALF + n * 16;
                        const u32x2 xo = xi[ai][m][bj][n]; const f32x4 a = acc[ai][bj][m][n];
                        const float x0 = __uint_as_float(xo.x << 16) + a[0], x1 = __uint_as_float(xo.x & 0xffff0000u) + a[1], x2 = __uint_as_float(xo.y << 16) + a[2], x3 = __uint_as_float(xo.y & 0xffff0000u) + a[3];
                        u32x2 w; w.x = cvt_pk_bf16(x0, x1); w.y = cvt_pk_bf16(x2, x3);
                        *(u32x2*)(xb + off) = w;
                        const float r0 = __uint_as_float(w.x << 16), r1 = __uint_as_float(w.x & 0xffff0000u), r2 = __uint_as_float(w.y << 16), r3 = __uint_as_float(w.y & 0xffff0000u);
                        ss += (r0 * r0 + r1 * r1) + (r2 * r2 + r3 * r3);
                    }
                ss += __shfl_xor(ss, 16); ss += __shfl_xor(ss, 32);
                if (fq == 0) P[(ai * HALF + wr * 64 + m * 16 + fr) * 4 + wc] = ss;
            }
        asm volatile("s_waitcnt lgkmcnt(0)" ::: "memory"); __builtin_amdgcn_s_barrier(); asm volatile("" ::: "memory");
        const int tid = wid * 64 + lane;
        if (tid < 256) { const f32x4 p = *(const PG8_LAS f32x4*)(P + tid * 4); rss[(size_t)(u.pm * BM + tid) * 4 + u.pn] = (p[0] + p[1]) + (p[2] + p[3]); }
        asm volatile("s_waitcnt lgkmcnt(0)" ::: "memory"); __builtin_amdgcn_s_barrier(); asm volatile("" ::: "memory");
    }
};
struct EpiUp {
    static constexpr bool PERM = true, AFTER_DRAIN = false;
    bf16_t* O; int ldc; const PG8_LAS float* tb;
    __device__ __forceinline__ void operator()(const f32x4 (&acc)[2][2][4][2], const Unit& u, int wr, int wc, int fr, int fq, int ui) const {
        const int row0 = u.pm * BM + wr * 64 + fr, col0 = u.pn * BM + wc * 32 + 8 * fq;
        const PG8_LAS float* rt = tb + ui * 256 + wr * 64 + fr;
#pragma unroll
        for (int ai = 0; ai < 2; ++ai)
#pragma unroll
            for (int m = 0; m < 4; ++m) {
                const int row = row0 + ai * HALF + m * 16;
                const float rstd = rt[ai * HALF + m * 16];
                bf16_t* rowp = O + (size_t)row * ldc + col0;
#pragma unroll
                for (int bj = 0; bj < 2; ++bj) {
                    f32x4 v0 = acc[ai][bj][m][0] * rstd, v1 = acc[ai][bj][m][1] * rstd;
#pragma unroll
                    for (int e = 0; e < 4; ++e) { const float a = v0[e] > 0.f ? v0[e] : 0.f, b = v1[e] > 0.f ? v1[e] : 0.f; v0[e] = a * a; v1[e] = b * b; }
                    u32x4 w; w.x = cvt_pk_bf16(v0[0], v0[1]); w.y = cvt_pk_bf16(v0[2], v0[3]); w.z = cvt_pk_bf16(v1[0], v1[1]); w.w = cvt_pk_bf16(v1[2], v1[3]);
                    *(u32x4*)(rowp + bj * HALF) = w;
                }
            }
    }
};

struct NoPre { __device__ __forceinline__ void operator()() const {} };
template <class Epi, class Sched, bool ALIGN_EPI = false, bool SP2 = false, class Pre = NoPre>
__device__ __forceinline__ void gemm_phase(PG8_LAS unsigned char* lds, const Gemm g, const Sched& S, const Epi& E, const Pre& pre = Pre()) {
    int tid_ = threadIdx.x; asm volatile("" : "+v"(tid_));
    const int tid = tid_, wid = __builtin_amdgcn_readfirstlane(tid >> 6), lane = tid & 63, wr = wid >> 2, wc = wid & 3, fr = lane & 15, fq = lane >> 4;
    const int K = g.K, nt = K / BK;
    unsigned voffA[2], voffB[2];
#pragma unroll
    for (int i = 0; i < 2; ++i) { int R, C; stage_rc(tid * 16 + i * 8192, R, C); const int Rb = Epi::PERM ? ((R & ~31) + perm32(R & 31)) : R;
        voffA[i] = (unsigned)(R * K + C) * 2u; voffB[i] = (unsigned)(Rb * K + C) * 2u; }
    const size_t kstep = (size_t)(BK * 2);
    const size_t hstep = (size_t)HALF * K * 2;
    const size_t tstep = 2 * hstep;
    const unsigned ldsw = (unsigned)wid * 1024u;
    const int aoff = lds_byte(wr * 64 + fr, fq * 8), boff = lds_byte(wc * 32 + fr, fq * 8);
#define PG8_SA(b, h) (((b) * 2 + (h)) * HTB)
#define PG8_SB(b, h) ((4 + (b) * 2 + (h)) * HTB)
#define PG8_STAGE(bufoff, gbase, voff) do { _Pragma("unroll") for (int _i = 0; _i < 2; ++_i) \
        __builtin_amdgcn_global_load_lds((const unsigned*)((const char*)(gbase) + (voff)[_i]), (PG8_LAS unsigned*)(lds + (bufoff) + ldsw + _i * 8192), 16, 0, 0); } while (0)
#define PG8_LDA(dst, b, h) do { _Pragma("unroll") for (int m = 0; m < 4; ++m) _Pragma("unroll") for (int k = 0; k < 2; ++k) dst[m][k] = *(const PG8_LAS bf16x8*)(lds + PG8_SA(b, h) + aoff + m * 2048 + k * 1024); } while (0)
#define PG8_LDB(dst, b, h) do { _Pragma("unroll") for (int n = 0; n < 2; ++n) _Pragma("unroll") for (int k = 0; k < 2; ++k) dst[n][k] = *(const PG8_LAS bf16x8*)(lds + PG8_SB(b, h) + boff + n * 2048 + k * 1024); } while (0)
#define PG8_MMA(ai, bj, At, Bt) do { __builtin_amdgcn_s_setprio(1); _Pragma("unroll") for (int m = 0; m < 4; ++m) _Pragma("unroll") for (int n = 0; n < 2; ++n) _Pragma("unroll") for (int k = 0; k < 2; ++k) \
        acc[ai][bj][m][n] = __builtin_amdgcn_mfma_f32_16x16x32_bf16(Bt[n][k], At[m][k], acc[ai][bj][m][n], 0, 0, 0); __builtin_amdgcn_s_setprio(0); } while (0)
#define PG8_WAIT_V(n) asm volatile("s_waitcnt vmcnt(" #n ")" ::: "memory")
#define PG8_WAIT_L(n) asm volatile("s_waitcnt lgkmcnt(" #n ")" ::: "memory")
#define PG8_BAR __builtin_amdgcn_s_barrier()
#define PG8_SCHED __builtin_amdgcn_sched_barrier(0)
    Unit cur, nxt; int ui = 0;
    if (!S.next(0, cur)) return;
    f32x4 acc[2][2][4][2];
#pragma unroll
    for (int a = 0; a < 2; ++a)
#pragma unroll
        for (int b = 0; b < 2; ++b)
#pragma unroll
            for (int m = 0; m < 4; ++m)
#pragma unroll
                for (int n = 0; n < 2; ++n) acc[a][b][m][n] = (f32x4){0.f, 0.f, 0.f, 0.f};
    bf16x8 At[4][2], B0[2][2], B1[2][2];
    const char* cA = (const char*)g.A + (size_t)cur.pm * tstep; const char* cB = (const char*)g.Bt + (size_t)cur.pn * tstep;
    S.a_ready(cur);
    if constexpr (SP2) {
        PG8_STAGE(PG8_SB(0, 0), cB, voffB); PG8_STAGE(PG8_SB(0, 1), cB + hstep, voffB); PG8_STAGE(PG8_SA(0, 0), cA, voffA); PG8_STAGE(PG8_SA(0, 1), cA + hstep, voffA);
        pre();
        if (wr == 1) PG8_BAR;
        PG8_WAIT_V(2); PG8_BAR;
        PG8_STAGE(PG8_SB(1, 0), cB + kstep, voffB); PG8_STAGE(PG8_SA(1, 0), cA + kstep, voffA); PG8_STAGE(PG8_SB(1, 1), cB + hstep + kstep, voffB);
        PG8_WAIT_V(6); PG8_BAR;
    } else {
        PG8_STAGE(PG8_SB(0, 0), cB, voffB); PG8_STAGE(PG8_SA(0, 0), cA, voffA); PG8_STAGE(PG8_SB(0, 1), cB + hstep, voffB); PG8_STAGE(PG8_SA(0, 1), cA + hstep, voffA);
        if (wr == 1) PG8_BAR;
        PG8_WAIT_V(4); PG8_BAR;
        PG8_STAGE(PG8_SB(1, 0), cB + kstep, voffB); PG8_STAGE(PG8_SA(1, 0), cA + kstep, voffA); PG8_STAGE(PG8_SB(1, 1), cB + hstep + kstep, voffB);
        PG8_WAIT_V(6); PG8_BAR;
    }
    for (;;) {
        const bool has_next = S.next(ui + 1, nxt);
        const char* nA = has_next ? (const char*)g.A + (size_t)nxt.pm * tstep : cA; const char* nB = has_next ? (const char*)g.Bt + (size_t)nxt.pn * tstep : cB;
        for (int t = 0; t < nt; t += 2) {
            const bool last = (t == nt - 2);
            const char* a1 = cA + (size_t)(t + 1) * kstep;
            const char* a2 = last ? nA : cA + (size_t)(t + 2) * kstep; const char* b2 = last ? nB : cB + (size_t)(t + 2) * kstep;
            const char* a3 = a2 + kstep; const char* b3 = b2 + kstep;
            if (last && has_next) S.a_ready(nxt);
            if constexpr (SP2) {
            PG8_LDB(B0, 0, 0); PG8_LDB(B1, 0, 1); PG8_SCHED; PG8_LDA(At, 0, 0); PG8_STAGE(PG8_SA(1, 1), a1 + hstep, voffA);
            PG8_WAIT_V(8); PG8_WAIT_L(0); PG8_BAR; PG8_MMA(0, 0, At, B0); PG8_MMA(0, 1, At, B1); PG8_BAR; PG8_SCHED;
            PG8_LDA(At, 0, 1); PG8_STAGE(PG8_SB(0, 0), b2, voffB); PG8_STAGE(PG8_SB(0, 1), b2 + hstep, voffB); PG8_STAGE(PG8_SA(0, 0), a2, voffA);
            PG8_WAIT_V(8); PG8_WAIT_L(0); PG8_BAR; PG8_MMA(1, 0, At, B0); PG8_MMA(1, 1, At, B1); PG8_BAR; PG8_SCHED;
            PG8_LDB(B0, 1, 0); PG8_LDB(B1, 1, 1); PG8_SCHED; PG8_LDA(At, 1, 0); PG8_STAGE(PG8_SA(0, 1), a2 + hstep, voffA);
            PG8_WAIT_V(8); PG8_WAIT_L(0); PG8_BAR; PG8_MMA(0, 0, At, B0); PG8_MMA(0, 1, At, B1); PG8_BAR; PG8_SCHED;
            PG8_LDA(At, 1, 1); PG8_STAGE(PG8_SB(1, 0), b3, voffB); PG8_STAGE(PG8_SB(1, 1), b3 + hstep, voffB); PG8_STAGE(PG8_SA(1, 0), a3, voffA);
            PG8_WAIT_V(8); PG8_WAIT_L(0); PG8_BAR; PG8_MMA(1, 0, At, B0); PG8_MMA(1, 1, At, B1); PG8_BAR; PG8_SCHED;
            } else {
            PG8_LDB(B0, 0, 0); PG8_SCHED; PG8_LDA(At, 0, 0); PG8_STAGE(PG8_SA(1, 1), a1 + hstep, voffA);
            PG8_WAIT_L(8); PG8_BAR; PG8_WAIT_L(0); PG8_MMA(0, 0, At, B0); PG8_BAR; PG8_SCHED;
            PG8_LDB(B1, 0, 1); PG8_STAGE(PG8_SB(0, 0), b2, voffB);
            PG8_BAR; PG8_WAIT_L(0); PG8_MMA(0, 1, At, B1); PG8_BAR;
            PG8_LDA(At, 0, 1); PG8_STAGE(PG8_SA(0, 0), a2, voffA);
            PG8_BAR; PG8_WAIT_L(0); PG8_MMA(1, 0, At, B0); PG8_BAR; PG8_SCHED;
            PG8_STAGE(PG8_SB(0, 1), b2 + hstep, voffB);
            PG8_WAIT_V(6); PG8_BAR; PG8_MMA(1, 1, At, B1); PG8_BAR;
            PG8_LDB(B0, 1, 0); PG8_SCHED; PG8_LDA(At, 1, 0); PG8_STAGE(PG8_SA(0, 1), a2 + hstep, voffA);
            PG8_WAIT_L(8); PG8_BAR; PG8_WAIT_L(0); PG8_MMA(0, 0, At, B0); PG8_BAR; PG8_SCHED;
            PG8_LDB(B1, 1, 1); PG8_STAGE(PG8_SB(1, 0), b3, voffB);
            PG8_BAR; PG8_WAIT_L(0); PG8_MMA(0, 1, At, B1); PG8_BAR;
            PG8_LDA(At, 1, 1); PG8_STAGE(PG8_SA(1, 0), a3, voffA);
            PG8_BAR; PG8_WAIT_L(0); PG8_MMA(1, 0, At, B0); PG8_BAR; PG8_SCHED;
            PG8_STAGE(PG8_SB(1, 1), b3 + hstep, voffB);
            PG8_WAIT_V(6); PG8_BAR; PG8_MMA(1, 1, At, B1); PG8_BAR;
            }
        }
        if constexpr (ALIGN_EPI) { if (wr == 0) PG8_BAR; }
        if constexpr (!Epi::AFTER_DRAIN) { E(acc, cur, wr, wc, fr, fq, ui); S.done(cur); }
        if (!has_next) break;
#pragma unroll
        for (int a = 0; a < 2; ++a)
#pragma unroll
            for (int b = 0; b < 2; ++b)
#pragma unroll
                for (int m = 0; m < 4; ++m)
#pragma unroll
                    for (int n = 0; n < 2; ++n) acc[a][b][m][n] = (f32x4){0.f, 0.f, 0.f, 0.f};
        cur = nxt; cA = nA; cB = nB; ++ui;
        if constexpr (ALIGN_EPI) { if (wr == 1) PG8_BAR; }
    }
    PG8_WAIT_V(0);
    if constexpr (!ALIGN_EPI) { if (wr == 0) PG8_BAR; }
    PG8_BAR;
    if constexpr (Epi::AFTER_DRAIN) { E.fused(acc, cur, wr, wc, fr, fq, lds, wid, lane); S.done(cur); }
#undef PG8_SA
#undef PG8_SB
#undef PG8_STAGE
#undef PG8_LDA
#undef PG8_LDB
#undef PG8_MMA
#undef PG8_WAIT_V
#undef PG8_WAIT_L
#undef PG8_BAR
#undef PG8_SCHED
}
}
#define GAS __attribute__((address_space(1)))
#define LAS __attribute__((address_space(3)))
typedef unsigned short bf16;
typedef unsigned v4u __attribute__((ext_vector_type(4)));
typedef float f32x4 __attribute__((ext_vector_type(4)));
typedef short bf16x8 __attribute__((ext_vector_type(8)));
typedef GAS unsigned gu32;
typedef GAS unsigned long long gu64;
#define RLX_AGENT __ATOMIC_RELAXED, __HIP_MEMORY_SCOPE_AGENT
#define LDS_WAIT() asm volatile("s_waitcnt lgkmcnt(0)" ::: "memory")
#define VM_WAIT() asm volatile("s_waitcnt vmcnt(0)" ::: "memory")
__device__ __forceinline__ unsigned long long rt() { return __builtin_amdgcn_s_memrealtime(); }
__device__ __forceinline__ unsigned f2bf(float f) { unsigned u = __builtin_bit_cast(unsigned, f); return (u + 0x7fffu + ((u >> 16) & 1u)) >> 16; }
__device__ __forceinline__ unsigned pk2(float lo, float hi) { return f2bf(lo) | (f2bf(hi) << 16); }

#define XB_TMO      128
#define XB_XCNT(j)  (256  + 64 * (j))
#define XB_XSUB(j)  (1280 + 64 * (j))
#define XB_XGEN(j)  (2304 + 64 * (j))
#define XB_TOP      3328
#define XB_TOPGEN   3392
#define XCD_BAR_WORDS 3456
#define XB_SPIN_CAP (1u << 18)

__device__ __forceinline__ unsigned xb_ld(unsigned* p)              { return __hip_atomic_load(p, __ATOMIC_RELAXED, __HIP_MEMORY_SCOPE_AGENT); }
__device__ __forceinline__ unsigned xb_add(unsigned* p, unsigned v) { return __hip_atomic_fetch_add(p, v, __ATOMIC_RELAXED, __HIP_MEMORY_SCOPE_AGENT); }
__device__ __forceinline__ unsigned xb_xcc_id() { return (unsigned)__builtin_amdgcn_s_getreg((3 << 11) | 20) & 0xFu; }
#define XB_SPIN(cond, bar) do { unsigned _sp = 0; while (cond) { __builtin_amdgcn_s_sleep(1); \
    if ((++_sp & 255u) == 0u) { if (xb_ld(&(bar)[XB_TMO])) break; if (_sp > XB_SPIN_CAP) { atomicAdd(&(bar)[XB_TMO], 1u); break; } } } } while (0)

struct XcdBarrier {
    unsigned* bar; unsigned x;
    volatile LAS unsigned* st;
};

__device__ __forceinline__ XcdBarrier xcd_barrier_post(unsigned* bar, volatile LAS unsigned* st) {
    XcdBarrier b; b.bar = bar; b.x = xb_xcc_id(); b.st = st;
    if (threadIdx.x == 0) (void)xb_add(&bar[XB_XCNT(b.x)], 1u);
    return b;
}
__device__ __forceinline__ void xcd_barrier_complete(unsigned* bar, unsigned x, unsigned& nloc, unsigned& nx) {
    const unsigned G = gridDim.x * gridDim.y * gridDim.z;
    unsigned sum, cnt, mine, sp = 0u;
    for (;;) {
        sum = 0u; cnt = 0u; mine = 0u;
#pragma unroll
        for (unsigned j = 0; j < 16; ++j) { const unsigned c = xb_ld(&bar[XB_XCNT(j)]); sum += c; cnt += (c > 0u) ? 1u : 0u; mine = (j == x) ? c : mine; }
        if (sum == G) break;
        __builtin_amdgcn_s_sleep(1);
        if ((++sp & 255u) == 0u) { if (xb_ld(&bar[XB_TMO])) break; if (sp > XB_SPIN_CAP) { atomicAdd(&bar[XB_TMO], 1u); break; } }
    }
    nloc = mine > 0u ? mine : 1u; nx = cnt > 0u ? cnt : 1u;
}

__device__ __forceinline__ void xcd_barrier(const XcdBarrier& b) {
    asm volatile("s_waitcnt vmcnt(0)" ::: "memory");
    __syncthreads();
    if (threadIdx.x == 0) {
        unsigned* bar = b.bar;
        __builtin_amdgcn_s_waitcnt(0);
        unsigned nloc = b.st[0], nx = b.st[1];
        if (nloc == 0u) { xcd_barrier_complete(bar, b.x, nloc, nx); b.st[0] = nloc; b.st[1] = nx; }
        const unsigned old = xb_add(&bar[XB_XSUB(b.x)], 1u);
        const unsigned gen = old / nloc;
        if (old + 1u == (gen + 1u) * nloc) {
            __builtin_amdgcn_fence(__ATOMIC_RELEASE, "agent");
            asm volatile("s_waitcnt vmcnt(0)" ::: "memory");
            const unsigned og = xb_add(&bar[XB_TOP], 1u);
            const unsigned tg = og / nx;
            if (og + 1u == (tg + 1u) * nx) xb_add(&bar[XB_TOPGEN], 1u);
            else XB_SPIN(xb_ld(&bar[XB_TOPGEN]) == tg, bar);
            __builtin_amdgcn_fence(__ATOMIC_ACQUIRE, "agent");
            xb_add(&bar[XB_XGEN(b.x)], 1u);
            asm volatile("s_waitcnt vmcnt(0)" ::: "memory");
        } else {
            XB_SPIN(xb_ld(&bar[XB_XGEN(b.x)]) == gen, bar);
            __builtin_amdgcn_fence(__ATOMIC_ACQUIRE, "agent");
            asm volatile("s_waitcnt vmcnt(0)" ::: "memory");
        }
    }
    __syncthreads();
}
#include <hip/hip_bf16.h>
#include <cmath>
namespace attc {
using bf16=__hip_bfloat16;
using bf16x8=__attribute__((ext_vector_type(8)))short;
using s16x4=__attribute__((ext_vector_type(4)))short;
using f32x16=__attribute__((ext_vector_type(16)))float;
using u32x4=__attribute__((ext_vector_type(4)))unsigned;
constexpr int BATCH=8,NHEAD=16,SEQ=2048,D=64,QP=1536,KP=1536,OP=1024;
constexpr int NW=8,QBLK=32,QB=QBLK*NW,KVBLK=64,NQB=SEQ/QB;
constexpr int ATTN_UNIT_ROWS=QB;
__device__ __forceinline__ int crow(int r,int hi){return (r&3)+8*(r>>2)+4*hi;}
#define SBAR() __builtin_amdgcn_sched_barrier(0)
__device__ __forceinline__ void cmask(f32x16&p0,f32x16&p1,int jb,int qrel,int hi){
  const float NEG=-INFINITY; int kb=64*jb+4*hi;
  #pragma unroll
  for(int r=0;r<16;++r){int kv=kb+(r&3)+8*(r>>2); if(kv>qrel)p0[r]=NEG; if(kv+32>qrel)p1[r]=NEG;}
}

constexpr int NSLOT=3, SLOTB=8192;
constexpr int LDS_K=0, LDS_V=NSLOT*SLOTB, LDS_WS=2*NSLOT*SLOTB, LDS_OST=LDS_WS+NW*64*4, LDS_BYTES=LDS_OST+NW*4096;
constexpr float C2=0.125f*1.4426950408889634f;
__device__ __forceinline__ void glds16(const void*gsrc,unsigned lds_dst){unsigned keep;
  asm volatile("s_mov_b32 %0, m0\n\ts_mov_b32 m0, %2\n\ts_nop 0\n\tglobal_load_lds_dwordx4 %1, off\n\ts_mov_b32 m0, %0":"=&s"(keep):"v"(gsrc),"s"(lds_dst):"memory");}
__device__ __forceinline__ float max3f(float a,float b,float c){float r;asm("v_max3_f32 %0, %1, %2, %3":"=v"(r):"v"(a),"v"(b),"v"(c));return r;}
__device__ __forceinline__ float max2f(float a,float b){float r;asm("v_max_f32_e32 %0, %1, %2":"=v"(r):"v"(a),"v"(b));return r;}
__device__ __forceinline__ float fadd_s(float a,float b){float r;asm("v_add_f32_e32 %0, %1, %2":"=v"(r):"v"(a),"v"(b));return r;}
__device__ __forceinline__ float fsub_s(float a,float b){float r;asm("v_sub_f32_e32 %0, %1, %2":"=v"(r):"v"(a),"v"(b));return r;}
typedef float f32x2_t __attribute__((ext_vector_type(2))); typedef __bf16 bf16x2_t __attribute__((ext_vector_type(2)));
__device__ __forceinline__ unsigned cvtpk_s(float lo,float hi){f32x2_t v={lo,hi};bf16x2_t b=__builtin_convertvector(v,bf16x2_t);return __builtin_bit_cast(unsigned,b);}
#define WAIT_BAR(N) asm volatile("s_waitcnt vmcnt(" #N ") lgkmcnt(0)\n\ts_barrier":::"memory")

__device__ __forceinline__ void qkt(f32x16&p0,f32x16&p1,const char*Kslot,const bf16x8*qr,const f32x16&negm,int r32,int hi){
  const char*kb=Kslot+hi*1024+r32*16;
  #pragma unroll
  for(int d0=0;d0<4;++d0){
    const bf16x8 b0=*reinterpret_cast<const bf16x8*>(kb+d0*2048);
    const bf16x8 b1=*reinterpret_cast<const bf16x8*>(kb+d0*2048+512);
    if(d0==0){p0=__builtin_amdgcn_mfma_f32_32x32x16_bf16(b0,qr[0],negm,0,0,0);p1=__builtin_amdgcn_mfma_f32_32x32x16_bf16(b1,qr[0],negm,0,0,0);}
    else{p0=__builtin_amdgcn_mfma_f32_32x32x16_bf16(b0,qr[d0],p0,0,0,0);p1=__builtin_amdgcn_mfma_f32_32x32x16_bf16(b1,qr[d0],p1,0,0,0);}}
}
typedef __attribute__((address_space(3))) const char* lds_cptr;
typedef short v4i16_t __attribute__((ext_vector_type(4)));
__device__ __forceinline__ void kload8(bf16x8*kf,lds_cptr kp){
  kf[0]=*(const __attribute__((address_space(3))) bf16x8*)(kp);      kf[1]=*(const __attribute__((address_space(3))) bf16x8*)(kp+512);
  kf[2]=*(const __attribute__((address_space(3))) bf16x8*)(kp+2048); kf[3]=*(const __attribute__((address_space(3))) bf16x8*)(kp+2560);
  kf[4]=*(const __attribute__((address_space(3))) bf16x8*)(kp+4096); kf[5]=*(const __attribute__((address_space(3))) bf16x8*)(kp+4608);
  kf[6]=*(const __attribute__((address_space(3))) bf16x8*)(kp+6144); kf[7]=*(const __attribute__((address_space(3))) bf16x8*)(kp+6656);
}
__device__ __forceinline__ void kload2(bf16x8*kf,lds_cptr kp,int j){ kf[2*j]=*(const __attribute__((address_space(3))) bf16x8*)(kp+j*2048); kf[2*j+1]=*(const __attribute__((address_space(3))) bf16x8*)(kp+j*2048+512); }
__device__ __forceinline__ s16x4 vtr(lds_cptr p){ return __builtin_bit_cast(s16x4,__builtin_amdgcn_ds_read_tr16_b64_v4i16((__attribute__((address_space(3))) v4i16_t*)p)); }
__device__ __forceinline__ float rowmax(const f32x16&p0,const f32x16&p1){
  float a=max3f(p0[0],p0[1],p1[0]),b=max3f(p0[2],p0[3],p1[1]);a=max3f(a,p1[2],p1[3]);
  #pragma unroll
  for(int r=4;r<16;r+=4){a=max3f(a,p0[r],p0[r+1]);b=max3f(b,p0[r+2],p0[r+3]);a=max3f(a,p1[r],p1[r+1]);b=max3f(b,p1[r+2],p1[r+3]);}
  const float m=max2f(a,b);
  auto rr=__builtin_amdgcn_permlane32_swap(__float_as_uint(m),__float_as_uint(m),false,false);
  return max2f(__uint_as_float(rr[0]),__uint_as_float(rr[1]));
}
__device__ __forceinline__ void pv(f32x16*o,int vb,bf16x8 pa0,bf16x8 pa1,bf16x8 pa2,bf16x8 pa3){
  #pragma unroll
  for(int d0=0;d0<2;++d0){s16x4 lo[4],hi[4];
    #pragma unroll
    for(int ks=0;ks<4;++ks){
      asm volatile("ds_read_b64_tr_b16 %0,%1 offset:%c2":"=&v"(lo[ks]):"v"(vb),"i"(d0*4096+ks*1024):"memory");
      asm volatile("ds_read_b64_tr_b16 %0,%1 offset:%c2":"=&v"(hi[ks]):"v"(vb),"i"(d0*4096+ks*1024+512):"memory");}
    asm volatile("s_waitcnt lgkmcnt(0)":::"memory");SBAR();
    #define PK(k) (bf16x8){lo[k][0],lo[k][1],lo[k][2],lo[k][3],hi[k][0],hi[k][1],hi[k][2],hi[k][3]}
    o[d0]=__builtin_amdgcn_mfma_f32_32x32x16_bf16(pa0,PK(0),o[d0],0,0,0);
    o[d0]=__builtin_amdgcn_mfma_f32_32x32x16_bf16(pa1,PK(1),o[d0],0,0,0);
    o[d0]=__builtin_amdgcn_mfma_f32_32x32x16_bf16(pa2,PK(2),o[d0],0,0,0);
    o[d0]=__builtin_amdgcn_mfma_f32_32x32x16_bf16(pa3,PK(3),o[d0],0,0,0);
    #undef PK
  }
}

#ifndef ATTN_STORE16
#define ATTN_STORE16(p,v) (*(u32x4*)(p)=(v))
#endif
template<int THRL> __device__ __forceinline__ void attn_unit(int b,int h,int hk,int qb,const bf16*Q,const bf16*__restrict__ K,const bf16*__restrict__ V,bf16*O,char*shm){
  int tid_=threadIdx.x; asm volatile("":"+v"(tid_));
  const int tid=tid_,lane=tid&63,r32=lane&31,hi=lane>>5; const int wid=__builtin_amdgcn_readfirstlane(tid>>6);
  const long rowbase=(long)b*SEQ; const int q0=qb*QB;
  const bf16*Qw=Q+(rowbase+q0+wid*QBLK)*QP+h*D;
  const bf16*Kh=K+rowbase*KP+hk*D,*Vh=V+rowbase*KP+hk*D;
  const unsigned lds0=(unsigned)(uintptr_t)shm;
  float*wsf=(float*)(shm+LDS_WS)+wid*64;
  const bf16*ksrc=Kh+(long)lane*KP+wid*8;
  const bf16*vsrc=Vh+(long)(16*(wid&3)+(lane>>2))*KP+(wid>>2)*32+(lane&3)*8;
  const unsigned kdst=lds0+LDS_K+wid*1024, vdst=lds0+LDS_V+wid*1024;
  #define DMA_K(t,slot) glds16(ksrc+(long)(t)*KVBLK*KP,(unsigned)__builtin_amdgcn_readfirstlane(kdst+(slot)))
  #define DMA_V(t,slot) glds16(vsrc+(long)(t)*KVBLK*KP,(unsigned)__builtin_amdgcn_readfirstlane(vdst+(slot)))
  const int vb0=(int)(lds0+LDS_V)+((lane>>4)&1)*32+(lane&3)*8+(4*hi+((lane&15)>>2))*64;
  const char*Kbase=shm+LDS_K; bf16x8 kf[8];
  const lds_cptr shm3=(lds_cptr)shm; const lds_cptr kp0=shm3+LDS_K+hi*1024+r32*16; const lds_cptr vp0=shm3+LDS_V+((lane>>4)&1)*32+(lane&3)*8+(4*hi+((lane&15)>>2))*64;
  const int NT=SEQ/KVBLK;
  DMA_K(0,0);DMA_V(0,0);DMA_K(1,SLOTB);
  bf16x8 qr[4];
  #pragma unroll
  for(int d0=0;d0<4;++d0)qr[d0]=*reinterpret_cast<const bf16x8*>(&Qw[(long)r32*QP+d0*16+hi*8]);
  float mhat=0.f,l_reg=0.f;f32x16 o[2];o[0]=f32x16{};o[1]=f32x16{};f32x16 negm=f32x16{};asm volatile("":"+v"(negm));
  const int qrel=wid*QBLK+r32;
  #define CMASK(P0,P1,t) do{}while(0)
  bool resc=false;
  #define START(P0,P1) do{ const float rm=rowmax(P0,P1); resc=false; \
    { const float dl=rm; mhat=fadd_s(mhat,dl); \
      _Pragma("unroll") for(int r=0;r<16;++r){P0[r]=fsub_s(P0[r],dl);P1[r]=fsub_s(P1[r],dl);} \
      _Pragma("unroll") for(int r=0;r<16;++r)negm[r]=-mhat; asm volatile("":"+v"(negm)); } \
    _Pragma("unroll") for(int r=0;r<16;++r)P0[r]=__builtin_amdgcn_exp2f(P0[r]); }while(0)
  #define RESC() do{ if(resc){ asm volatile("s_waitcnt lgkmcnt(0)":::"memory"); \
      _Pragma("unroll") for(int d_=0;d_<2;++d_) _Pragma("unroll") for(int r=0;r<16;++r)o[d_][r]*=wsf[crow(r,hi)]; } }while(0)
  f32x16 pA0,pA1,pB0,pB1;
  int sl_prev=0,sl_cur=0,sl_next=SLOTB;
  #define ROT() do{sl_prev=sl_cur;sl_cur=sl_next;sl_next=(sl_next==(NSLOT-1)*SLOTB)?0:sl_next+SLOTB;}while(0)
  DMA_K(2,2*SLOTB);
  WAIT_BAR(3);
  qkt(pA0,pA1,Kbase,qr,negm,r32,hi);asm volatile("s_nop 15\n\ts_nop 7":"+v"(pA0),"+v"(pA1));CMASK(pA0,pA1,0);
  START(pA0,pA1);
  _Pragma("unroll") for(int r=0;r<16;++r)pA1[r]=__builtin_amdgcn_exp2f(pA1[r]);
  WAIT_BAR(0);
  DMA_K(3,0);DMA_V(1,SLOTB);
  ROT();
  kload8(kf,kp0+sl_cur);
  WAIT_BAR(2);
  s16x4 vlo[8],vhi[8]; u32x4 pw0,pw1,pw2,pw3;
  #define PKW(P,B) cvtpk_s(P[B],P[B+1])
  #define PAF(k) __builtin_bit_cast(bf16x8,pw##k)
  #define VFR(i) (bf16x8){vlo[i][0],vlo[i][1],vlo[i][2],vlo[i][3],vhi[i][0],vhi[i][1],vhi[i][2],vhi[i][3]}
  #define PIN(x) asm volatile("":"+v"(x))
  #define MX3(a,b,c) __builtin_fmaxf(__builtin_fmaxf((a),(b)),(c))
  #define GAPA(MF,A0,A1,A2,A3,W0,W1,PW) do{ MF; sacc+=A0; sacc+=A1; sacc+=A2; sacc+=A3; PIN(sacc); W0; W1; PIN(PW); SBAR(); }while(0)
  #define EX(v) __builtin_amdgcn_exp2f(v)
  #define GAPB(MF,X,B) do{ MF; X[B]=EX(X[B]); X[B+1]=EX(X[B+1]); X[B+2]=EX(X[B+2]); X[B+3]=EX(X[B+3]); PIN(X); SBAR(); }while(0)
  #define VRD(i) do{ vlo[i]=vtr(vp_+(((i)>>2)*4096+((i)&3)*1024)); vhi[i]=vtr(vp_+(((i)>>2)*4096+((i)&3)*1024+512)); }while(0)
  #define KRD(G,j) do{ if(G){ kload2(kf,kp0+sl_next,j); SBAR(); } }while(0)
  #define STEP(C0,C1,P0,P1,t,GK,GV,GL) do{ SBAR(); \
    const lds_cptr vp_=vp0+sl_prev; \
    VRD(0); SBAR(); float sacc=(P0[0]+P0[1]); \
    GAPA(C0=__builtin_amdgcn_mfma_f32_32x32x16_bf16(kf[0],qr[0],negm,0,0,0), P0[2],P0[3],P0[4],P0[5],     pw0[0]=PKW(P0,0), pw0[1]=PKW(P0,2), pw0); \
    VRD(4); SBAR(); GAPA(C1=__builtin_amdgcn_mfma_f32_32x32x16_bf16(kf[1],qr[0],negm,0,0,0), P0[6],P0[7],P0[8],P0[9],     pw0[2]=PKW(P0,4), pw0[3]=PKW(P0,6), pw0); \
    VRD(1); SBAR(); GAPA(C0=__builtin_amdgcn_mfma_f32_32x32x16_bf16(kf[2],qr[1],C0,0,0,0),   P0[10],P0[11],P0[12],P0[13], pw1[0]=PKW(P0,8), pw1[1]=PKW(P0,10), pw1); \
    VRD(5); SBAR(); GAPA(C1=__builtin_amdgcn_mfma_f32_32x32x16_bf16(kf[3],qr[1],C1,0,0,0),   P0[14],P0[15],P1[0],P1[1],   pw1[2]=PKW(P0,12),pw1[3]=PKW(P0,14), pw1); \
    VRD(2); SBAR(); GAPA(C0=__builtin_amdgcn_mfma_f32_32x32x16_bf16(kf[4],qr[2],C0,0,0,0),   P1[2],P1[3],P1[4],P1[5],     pw2[0]=PKW(P1,0), pw2[1]=PKW(P1,2), pw2); \
    VRD(6); SBAR(); GAPA(C1=__builtin_amdgcn_mfma_f32_32x32x16_bf16(kf[5],qr[2],C1,0,0,0),   P1[6],P1[7],P1[8],P1[9],     pw2[2]=PKW(P1,4), pw2[3]=PKW(P1,6), pw2); \
    VRD(3); SBAR(); GAPA(C0=__builtin_amdgcn_mfma_f32_32x32x16_bf16(kf[6],qr[3],C0,0,0,0),   P1[10],P1[11],P1[12],P1[13], pw3[0]=PKW(P1,8), pw3[1]=PKW(P1,10), pw3); \
    VRD(7); SBAR(); GAPA(C1=__builtin_amdgcn_mfma_f32_32x32x16_bf16(kf[7],qr[3],C1,0,0,0),   P1[14],P1[15],0.f,0.f,       pw3[2]=PKW(P1,12),pw3[3]=PKW(P1,14), pw3); \
    l_reg+=sacc; \
    if(GK){DMA_K((t)+3,sl_cur);} if(GV){DMA_V((t)+1,sl_next);} \
    CMASK(C0,C1,t); \
    { float a=MX3(C0[0],C0[1],C1[0]),b=MX3(C0[2],C0[3],C1[1]); a=MX3(a,C1[2],C1[3]); \
      _Pragma("unroll") for(int r=4;r<16;r+=4){a=MX3(a,C0[r],C0[r+1]);b=MX3(b,C0[r+2],C0[r+3]);a=MX3(a,C1[r],C1[r+1]);b=MX3(b,C1[r+2],C1[r+3]);} \
      float rm=__builtin_fmaxf(a,b); { auto rr=__builtin_amdgcn_permlane32_swap(__float_as_uint(rm),__float_as_uint(rm),false,false); rm=__builtin_fmaxf(__uint_as_float(rr[0]),__uint_as_float(rr[1])); } \
      resc=false; \
      if(__builtin_expect(__any(rm>(float)THRL),0)){ const float dl=__builtin_fmaxf(rm,0.f); mhat+=dl; \
        _Pragma("unroll") for(int r=0;r<16;++r){C0[r]-=dl;C1[r]-=dl;} \
        _Pragma("unroll") for(int r=0;r<16;++r)negm[r]=-mhat; asm volatile("":"+v"(negm)); \
        const float f=__builtin_amdgcn_exp2f(-dl); l_reg*=f; if(hi==0)wsf[r32]=f; resc=true; } } \
    SBAR(); \
    GAPB(o[0]=__builtin_amdgcn_mfma_f32_32x32x16_bf16(PAF(0),VFR(0),o[0],0,0,0), C0,0); \
    GAPB(o[1]=__builtin_amdgcn_mfma_f32_32x32x16_bf16(PAF(0),VFR(4),o[1],0,0,0), C0,4); \
    KRD(GL,0); GAPB(o[0]=__builtin_amdgcn_mfma_f32_32x32x16_bf16(PAF(1),VFR(1),o[0],0,0,0), C0,8); \
    KRD(GL,1); GAPB(o[1]=__builtin_amdgcn_mfma_f32_32x32x16_bf16(PAF(1),VFR(5),o[1],0,0,0), C0,12); \
    KRD(GL,2); GAPB(o[0]=__builtin_amdgcn_mfma_f32_32x32x16_bf16(PAF(2),VFR(2),o[0],0,0,0), C1,0); \
    KRD(GL,3); GAPB(o[1]=__builtin_amdgcn_mfma_f32_32x32x16_bf16(PAF(2),VFR(6),o[1],0,0,0), C1,4); \
    GAPB(o[0]=__builtin_amdgcn_mfma_f32_32x32x16_bf16(PAF(3),VFR(3),o[0],0,0,0), C1,8); \
    GAPB(o[1]=__builtin_amdgcn_mfma_f32_32x32x16_bf16(PAF(3),VFR(7),o[1],0,0,0), C1,12); \
    }while(0)
  int t=1;
  #undef CMASK
  #define CMASK(P0,P1,t) do{}while(0)
  for(;t+5<NT;t+=2){
    STEP(pB0,pB1,pA0,pA1,t,true,true,true);     WAIT_BAR(2); RESC(); ROT();
    STEP(pA0,pA1,pB0,pB1,t+1,true,true,true);   WAIT_BAR(2); RESC(); ROT();
  }
  #undef CMASK
  #define CMASK(P0,P1,t) do{}while(0)
  #define ENDW(tt) do{ if((tt)+3<NT){WAIT_BAR(2);} else if((tt)+2<NT){WAIT_BAR(1);} else {WAIT_BAR(0);} }while(0)
  for(;t+1<NT;t+=2){
    STEP(pB0,pB1,pA0,pA1,t,(t+3<NT),(t+1<NT),(t+1<NT));       ENDW(t);   RESC(); ROT();
    STEP(pA0,pA1,pB0,pB1,t+1,(t+4<NT),(t+2<NT),(t+2<NT));     ENDW(t+1); RESC(); ROT();
  }
  STEP(pB0,pB1,pA0,pA1,NT-1,false,false,false); RESC();
  { float sacc=pB0[0]+pB0[1]; _Pragma("unroll") for(int r=2;r<16;++r)sacc+=pB0[r]; _Pragma("unroll") for(int r=0;r<16;++r)sacc+=pB1[r]; l_reg+=sacc;
    pw0=(u32x4){PKW(pB0,0),PKW(pB0,2),PKW(pB0,4),PKW(pB0,6)};pw1=(u32x4){PKW(pB0,8),PKW(pB0,10),PKW(pB0,12),PKW(pB0,14)};pw2=(u32x4){PKW(pB1,0),PKW(pB1,2),PKW(pB1,4),PKW(pB1,6)};pw3=(u32x4){PKW(pB1,8),PKW(pB1,10),PKW(pB1,12),PKW(pB1,14)};
    SBAR(); pv(o,vb0+sl_cur,PAF(0),PAF(1),PAF(2),PAF(3)); }
  #undef PKW
  #undef PAF
  #undef VFR
  #undef PIN
  #undef MX3
  #undef GAPA
  #undef GAPB
  #undef EX
  #undef VRD
  #undef KRD
  #undef STEP
  #undef ENDW
  {auto rr=__builtin_amdgcn_permlane32_swap(__float_as_uint(l_reg),__float_as_uint(l_reg),false,false);l_reg=__uint_as_float(rr[0])+__uint_as_float(rr[1]);}
  if(hi==0)wsf[32+r32]=l_reg;asm volatile("s_waitcnt lgkmcnt(0)":::"memory");
  float rli[16];
  #pragma unroll
  for(int r=0;r<16;++r)rli[r]=__builtin_amdgcn_rcpf(wsf[32+crow(r,hi)]);
  bf16*Ow=O+(rowbase+q0+wid*QBLK)*OP+h*D;
  { bf16*stg=(bf16*)(shm+LDS_OST)+wid*2048;
    #pragma unroll
    for(int r=0;r<16;++r){const int orow=crow(r,hi);
      #pragma unroll
      for(int d0=0;d0<2;++d0)stg[orow*64+d0*32+r32]=__float2bfloat16(o[d0][r]*rli[r]);}
    asm volatile("s_waitcnt lgkmcnt(0)":::"memory");
    #pragma unroll
    for(int i=0;i<4;++i){const int row=i*8+(lane>>3),ch=lane&7; const u32x4 v=*(const u32x4*)(stg+row*64+ch*8); ATTN_STORE16(Ow+(long)row*OP+ch*8,v);} }
  asm volatile("s_waitcnt lgkmcnt(0)\n\ts_barrier":::"memory");
  #undef DMA_K
  #undef DMA_V
  #undef CMASK
  #undef START
  #undef RESC
  #undef ROT
}
constexpr int ATTN_LDS_BYTES=LDS_BYTES;
struct AttnTensors { const bf16* Q; const bf16* K; const bf16* V; bf16* O; };
template<int THRL=8> __device__ __forceinline__ void attn_phase(char*lds,const AttnTensors&T,int vcu){
  const int grp=vcu>>3,j=vcu&7,b=grp>>2,hk=grp&3,h=hk*4+(j>>1);
  for(int i=0;i<4;++i) attn_unit<THRL>(b,h,hk,(j&1)*4+i,T.Q,T.K,T.V,T.O,lds);
}
#undef SBAR
#undef WAIT_BAR
}

namespace att {
typedef short bf16x8 __attribute__((ext_vector_type(8)));
typedef short s16x4 __attribute__((ext_vector_type(4)));
typedef short v4i16_t __attribute__((ext_vector_type(4)));
typedef float f32x16 __attribute__((ext_vector_type(16)));
typedef unsigned u32x4 __attribute__((ext_vector_type(4)));
typedef unsigned u32x2 __attribute__((ext_vector_type(2)));
typedef float f32x2_t __attribute__((ext_vector_type(2))); typedef __bf16 bf16x2_t __attribute__((ext_vector_type(2)));
typedef unsigned short bf16_t;
#define ALAS __attribute__((address_space(3)))
constexpr float LOG2E = 1.4426950408889634f;
__device__ __forceinline__ int crow(int r, int hi) { return (r & 3) + 8 * (r >> 2) + 4 * hi; }
__device__ __forceinline__ unsigned cvtpk(float lo, float hi) { f32x2_t v = {lo, hi}; bf16x2_t b = __builtin_convertvector(v, bf16x2_t); return __builtin_bit_cast(unsigned, b); }
__device__ __forceinline__ s16x4 vtr(const ALAS unsigned char* p) { return __builtin_bit_cast(s16x4, __builtin_amdgcn_ds_read_tr16_b64_v4i16((ALAS v4i16_t*)p)); }
__device__ __forceinline__ int clampi(int v, int lo, int hi) { return v < lo ? lo : (v > hi ? hi : v); }

struct AttnP { const bf16_t* Q; const bf16_t* K; const bf16_t* V; int pitch; bf16_t* O; float* lse; const float* rpb; int dlog; int g; };

constexpr int WAVE_LDS = 8192;

template <int MODE>
__device__ __forceinline__ void attn_unit(const AttnP& P, int u, ALAS unsigned char* wl, int lane_) {
    int lane = lane_; asm volatile("" : "+v"(lane));
    const int q = lane & 31, hi = lane >> 5;
    int b, h, hk, qtok, tok0, tstep, kstr, nt, jt0;
    int rq = 0, cq = 0, kstart = 0;
    if (MODE == 0) {
        const int dlog = P.dlog, d = 1 << dlog, nblk = 64 >> dlog;
        h = u & 15; int rest = u >> 4; const int blk = rest & (nblk - 1); rest >>= (6 - dlog); const int r = rest & (d - 1); b = rest >> dlog; hk = h;
        const int i0 = 32 * blk, L = 2048 >> dlog;
        qtok = b * 2048 + ((i0 + q) << dlog) + r;
        const int jlo = (i0 < 64) ? ((64 - i0) >> 5) : 0; int jhi = (L - i0 + 64) >> 5; if (jhi > 5) jhi = 5;
        jt0 = jlo; nt = jhi - jlo;
        tok0 = b * 2048 + ((i0 - 64 + 32 * jlo) << dlog) + r; tstep = 32 << dlog; kstr = d;
    } else if (MODE == 1) {
        h = u & 15; const int rest = u >> 4; const int cb = rest & 3, rp = (rest >> 2) & 15; b = rest >> 6; hk = h;
        rq = 2 * rp + (q >> 4); cq = 16 * cb + (q & 15);
        qtok = b * 2048 + rq * 64 + cq;
        kstart = clampi(16 * cb - 8, 0, 32);
        const int rs0 = clampi(2 * rp - 4, 0, 24), rs1 = clampi(2 * rp - 3, 0, 24);
        jt0 = rs0; nt = rs1 + 8 - rs0;
        tok0 = b * 2048 + rs0 * 64 + kstart; tstep = 64; kstr = 1;
    } else {
        const int qblk = u & 63; h = (u >> 6) & 15; b = u >> 10; hk = h >> 2;
        qtok = b * 2048 + 32 * qblk + q; jt0 = 0; nt = 64; tok0 = b * 2048; tstep = 32; kstr = 1;
    }
    const int pitch = P.pitch;
    ALAS float* tab = (ALAS float*)(wl + 4096);
    float madd[16];
    if (MODE == 1) {
#pragma unroll
        for (int k = 0; k < 9; ++k) { const int i = lane + 64 * k; const int j = i - 16;
            if (i < 560) tab[i] = (i >= 512) ? -__builtin_inff() : ((j >= 0 && j < 465) ? P.rpb[h * 465 + j] * LOG2E : 0.f); }
        const int o_ = clampi(cq - 8, 0, 48) - kstart;
#pragma unroll
        for (int r = 0; r < 16; ++r) madd[r] = ((unsigned)(crow(r, hi) - o_) < 16u) ? 0.f : -__builtin_inff();
    }
    bf16x8 qf[4];
    { const bf16_t* qp = P.Q + (size_t)qtok * pitch + h * 64 + hi * 8;
#pragma unroll
      for (int ks = 0; ks < 4; ++ks) qf[ks] = *(const bf16x8*)(qp + 16 * ks); }
    const bf16_t* kp = P.K + hk * 64 + hi * 8 + (size_t)(tok0 + q * kstr) * pitch;
    const bf16_t* vp = P.V + hk * 64 + (lane & 7) * 8 + (size_t)(tok0 + (lane >> 3) * kstr) * pitch;
    const size_t tstepb = (size_t)tstep * pitch, vpiece = (size_t)8 * kstr * pitch;
    const int vwoff = ((lane & 7) >> 2) * 2048 + (lane >> 3) * 64 + (lane & 3) * 16;
    const ALAS unsigned char* vb = wl + (4 * hi + ((lane & 15) >> 2)) * 64 + ((lane >> 4) & 1) * 32 + (lane & 3) * 8;
    bf16x8 kn[4], vn[4], k2[4], v2[4];
#pragma unroll
    for (int ks = 0; ks < 4; ++ks) kn[ks] = *(const bf16x8*)(kp + 16 * ks);
#pragma unroll
    for (int i = 0; i < 4; ++i) vn[i] = *(const bf16x8*)(vp + i * vpiece);
    { const size_t adv = (nt > 1) ? tstepb : 0;
        kp += adv; vp += adv;
#pragma unroll
        for (int ks = 0; ks < 4; ++ks) k2[ks] = *(const bf16x8*)(kp + 16 * ks);
#pragma unroll
        for (int i = 0; i < 4; ++i) v2[i] = *(const bf16x8*)(vp + i * vpiece);
    }
    f32x16 o0 = {}, o1 = {};
    float mrun = -1e30f, l = 0.f;
    for (int t = 0; t < nt; ++t) {
        bf16x8 kc[4], vc[4];
#pragma unroll
        for (int i = 0; i < 4; ++i) { kc[i] = kn[i]; vc[i] = vn[i]; kn[i] = k2[i]; vn[i] = v2[i]; }
        { const size_t adv = (t + 2 < nt) ? tstepb : 0;
            kp += adv; vp += adv;
#pragma unroll
            for (int ks = 0; ks < 4; ++ks) k2[ks] = *(const bf16x8*)(kp + 16 * ks);
#pragma unroll
            for (int i = 0; i < 4; ++i) v2[i] = *(const bf16x8*)(vp + i * vpiece);
        }
#pragma unroll
        for (int i = 0; i < 4; ++i) *(ALAS bf16x8*)(wl + vwoff + i * 512) = vc[i];
        f32x16 p = {};
#pragma unroll
        for (int ks = 0; ks < 4; ++ks) p = __builtin_amdgcn_mfma_f32_32x32x16_bf16(kc[ks], qf[ks], p, 0, 0, 0);
        const float NEG = -__builtin_inff();
        if (MODE == 0) {
            const int jt = jt0 + t;
            if (jt == 0) {
#pragma unroll
                for (int r = 0; r < 16; ++r) if (crow(r, hi) < q) p[r] = NEG;
            }
            if (jt == 4) {
#pragma unroll
                for (int r = 0; r < 16; ++r) if (crow(r, hi) > q) p[r] = NEG;
            }
        } else if (MODE == 1) {
            const int kr = jt0 + t, rsq = clampi(rq - 4, 0, 24);
            const bool row_ok = (kr >= rsq) && (kr < rsq + 8);
            const ALAS float* brow = tab + (row_ok ? 16 + (kr - rq + 7) * 31 + (kstart - cq + 15) + 4 * hi : 512 + 4 * hi);
#pragma unroll
            for (int r = 0; r < 16; ++r) p[r] = (p[r] + brow[(r & 3) + 8 * (r >> 2)]) + madd[r];
        }
        float mx = p[0];
#pragma unroll
        for (int r = 1; r < 16; ++r) mx = fmaxf(mx, p[r]);
        mx = fmaxf(mx, __shfl_xor(mx, 32));
        const float mn = fmaxf(mrun, mx);
        const float alpha = __builtin_amdgcn_exp2f(mrun - mn);
        mrun = mn;
        float rs = 0.f;
#pragma unroll
        for (int r = 0; r < 16; ++r) { p[r] = __builtin_amdgcn_exp2f(p[r] - mn); rs += p[r]; }
        l = l * alpha + rs;
        if (__any(alpha != 1.0f)) {
#pragma unroll
            for (int r = 0; r < 16; ++r) { o0[r] *= alpha; o1[r] *= alpha; }
        }
        u32x4 w0, w1;
        w0.x = cvtpk(p[0], p[1]); w0.y = cvtpk(p[2], p[3]); w0.z = cvtpk(p[4], p[5]); w0.w = cvtpk(p[6], p[7]);
        w1.x = cvtpk(p[8], p[9]); w1.y = cvtpk(p[10], p[11]); w1.z = cvtpk(p[12], p[13]); w1.w = cvtpk(p[14], p[15]);
        const bf16x8 pf0 = __builtin_bit_cast(bf16x8, w0), pf1 = __builtin_bit_cast(bf16x8, w1);
#define ATT_VF(off) ({ const s16x4 lo_ = vtr(vb + (off)), hi_ = vtr(vb + (off) + 512); (bf16x8){lo_[0], lo_[1], lo_[2], lo_[3], hi_[0], hi_[1], hi_[2], hi_[3]}; })
        { const bf16x8 v00 = ATT_VF(0), v01 = ATT_VF(1024), v10 = ATT_VF(2048), v11 = ATT_VF(2048 + 1024);
          o0 = __builtin_amdgcn_mfma_f32_32x32x16_bf16(v00, pf0, o0, 0, 0, 0);
          o1 = __builtin_amdgcn_mfma_f32_32x32x16_bf16(v10, pf0, o1, 0, 0, 0);
          o0 = __builtin_amdgcn_mfma_f32_32x32x16_bf16(v01, pf1, o0, 0, 0, 0);
          o1 = __builtin_amdgcn_mfma_f32_32x32x16_bf16(v11, pf1, o1, 0, 0, 0); }
#undef ATT_VF
    }
    l += __shfl_xor(l, 32);
    const float inv = 1.0f / l;
    float wc_ = inv, wp_ = 0.f;
    if (MODE == 0) {
        float lse_new = mrun + __builtin_amdgcn_logf(l);
        if (P.g > 0) {
            const float lp = P.lse[(size_t)qtok * 16 + h];
            const float mm = fmaxf(lp, lse_new), ep = __builtin_amdgcn_exp2f(lp - mm), ec = __builtin_amdgcn_exp2f(lse_new - mm), den = ep + ec;
            wp_ = ep / den; wc_ = inv * (ec / den); lse_new = mm + __builtin_amdgcn_logf(den);
        }
        if (P.g < 2 && hi == 0) P.lse[(size_t)qtok * 16 + h] = lse_new;
    }
    bf16_t* op = P.O + (size_t)qtok * 1024 + h * 64 + 4 * hi;
#pragma unroll
    for (int db = 0; db < 2; ++db)
#pragma unroll
        for (int rr = 0; rr < 4; ++rr) {
            float v[4];
#pragma unroll
            for (int e = 0; e < 4; ++e) v[e] = (db == 0 ? o0[4 * rr + e] : o1[4 * rr + e]) * wc_;
            u32x2* dst = (u32x2*)(op + 32 * db + 8 * rr);
            if (MODE == 0 && P.g > 0) {
                const u32x2 pv = *dst;
                v[0] += wp_ * __uint_as_float(pv.x << 16); v[1] += wp_ * __uint_as_float(pv.x & 0xffff0000u);
                v[2] += wp_ * __uint_as_float(pv.y << 16); v[3] += wp_ * __uint_as_float(pv.y & 0xffff0000u);
            }
            u32x2 w; w.x = cvtpk(v[0], v[1]); w.y = cvtpk(v[2], v[3]);
            *dst = w;
        }
}
template <int MODE>
__device__ __forceinline__ void attn_phase(const AttnP& P, ALAS unsigned char* lds, int vcu, int wave, int lane) {
    ALAS unsigned char* wl = lds + wave * WAVE_LDS;
    for (int k = 0; k < 4; ++k) {
        int u;
        if (MODE == 2) { const int grp = vcu >> 3, j = vcu & 7, b = grp >> 2, kvh = grp & 3, h = kvh * 4 + (j >> 1), qblk = (j & 1) * 32 + k * 8 + wave; u = ((b * 16 + h) << 6) | qblk; }
        else u = vcu * 32 + k * 8 + wave;
        attn_unit<MODE>(P, u, wl, lane);
    }
}
}

namespace atta {
typedef short bf16x8 __attribute__((ext_vector_type(8)));
typedef short s16x4 __attribute__((ext_vector_type(4)));
typedef float f32x16 __attribute__((ext_vector_type(16)));
typedef unsigned u32x4 __attribute__((ext_vector_type(4)));
typedef unsigned u32x2 __attribute__((ext_vector_type(2)));
typedef unsigned short bf16_t;
constexpr int K_OFF = 0, V_OFF = 49152, ST_OFF = 98304, ST_ROW = 144, ST_WAVE = 32 * ST_ROW + 128, LDS_NEED = ST_OFF + 8 * ST_WAVE;
struct Params { const bf16_t* qkv; bf16_t* O; float* lse; int dlog; int g; };
using att::crow; using att::cvtpk; using att::vtr;

__device__ __forceinline__ void phase(const Params& P, ALAS unsigned char* lds, int vcu, int lane_) {
    int tid_ = threadIdx.x; asm volatile("" : "+v"(tid_));
    const int lane = tid_ & 63, w = __builtin_amdgcn_readfirstlane(tid_ >> 6), q = lane & 31, hi = lane >> 5;
    (void)lane_;
    const int dlog = P.dlog, L = 2048 >> dlog, g = P.g;
    const int npieces = (dlog == 4) ? 8 : 12;
    ALAS unsigned char* stg = lds + ST_OFF + w * ST_WAVE;
    ALAS float* stw = (ALAS float*)(stg + 32 * ST_ROW);
    bf16x8 qf[4]; u32x4 prevo[4]; float lprev = 0.f;
#define ATTA_DECODE(k) \
    const int u_ = vcu * 4 + (k), su = u_ & 7, h = (u_ >> 3) & 15, b = u_ >> 7; \
    const int rres = (dlog == 0) ? 0 : (dlog == 2 ? (su >> 1) : 2 * su + (w >> 2)); \
    const int I0 = (dlog == 0) ? 256 * su : (dlog == 2 ? 256 * (su & 1) : 0); \
    const int i0 = (dlog == 4) ? 32 * (w & 3) : I0 + 32 * w; \
    const int tb = (dlog == 4) ? 4 * (w >> 2) + (w & 3) - 2 : w;
#define ATTA_ISSUE(k) do { ATTA_DECODE(k) \
        for (int i = 0; i < npieces; ++i) { const int p = w + 8 * i, T = p >> 3, sub = p & 7; \
            const int res = (dlog == 0) ? 0 : (dlog == 2 ? (su >> 1) : 2 * su + (T >> 2)); \
            const int key0 = (dlog == 4) ? 32 * (T & 3) : I0 - 64 + 32 * T; \
            if (key0 >= 0 && key0 < L) { \
                if (sub < 4) { const int keyl = 8 * sub + (lane >> 3), cp = lane & 7; \
                    const bf16_t* src = P.qkv + (size_t)(b * 2048 + ((key0 + keyl) << dlog) + res) * 3072 + 1024 + h * 64 + ((cp ^ (keyl & 7)) * 8); \
                    __builtin_amdgcn_global_load_lds((const unsigned*)src, (ALAS unsigned*)(lds + K_OFF + T * 4096 + sub * 1024), 16, 0, 0); } \
                else { const int s2 = sub - 4, dh = s2 >> 1, kh = s2 & 1, keyl = 16 * kh + (lane >> 2), c4 = lane & 3; \
                    const bf16_t* src = P.qkv + (size_t)(b * 2048 + ((key0 + keyl) << dlog) + res) * 3072 + 2048 + h * 64 + dh * 32 + c4 * 8; \
                    __builtin_amdgcn_global_load_lds((const unsigned*)src, (ALAS unsigned*)(lds + V_OFF + T * 4096 + dh * 2048 + kh * 1024), 16, 0, 0); } } } \
        { const bf16_t* qp = P.qkv + (size_t)(b * 2048 + ((i0 + q) << dlog) + rres) * 3072 + h * 64 + hi * 8; \
          _Pragma("unroll") for (int ks = 0; ks < 4; ++ks) qf[ks] = *(const bf16x8*)(qp + 16 * ks); } \
        if (g > 0) { \
          _Pragma("unroll") for (int i = 0; i < 4; ++i) { const int row = 8 * i + (lane >> 3); \
              prevo[i] = *(const u32x4*)(P.O + (size_t)(b * 2048 + ((i0 + row) << dlog) + rres) * 1024 + h * 64 + (lane & 7) * 8); } \
          lprev = P.lse[(size_t)(b * 2048 + ((i0 + q) << dlog) + rres) * 16 + h]; } \
    } while (0)

    ATTA_ISSUE(0);
    for (int k = 0; k < 4; ++k) {
        asm volatile("s_waitcnt vmcnt(0)" ::: "memory"); __builtin_amdgcn_s_barrier(); asm volatile("" ::: "memory");
        ATTA_DECODE(k)
        f32x16 p[5];
        const float NEG = -__builtin_inff();
#pragma unroll
        for (int jt = 0; jt < 5; ++jt) {
            const int key0 = i0 - 64 + 32 * jt;
            if (key0 >= 0 && key0 < L) {
                const ALAS unsigned char* kt = lds + K_OFF + (tb + jt) * 4096 + q * 128;
                f32x16 acc = {};
#pragma unroll
                for (int ks = 0; ks < 4; ++ks) { const bf16x8 kf = *(const ALAS bf16x8*)(kt + (((2 * ks + hi) ^ (q & 7)) * 16)); acc = __builtin_amdgcn_mfma_f32_32x32x16_bf16(kf, qf[ks], acc, 0, 0, 0); }
                if (jt == 0) {
#pragma unroll
                    for (int r = 0; r < 16; ++r) if (crow(r, hi) < q) acc[r] = NEG;
                }
                if (jt == 4) {
#pragma unroll
                    for (int r = 0; r < 16; ++r) if (crow(r, hi) > q) acc[r] = NEG;
                }
                p[jt] = acc;
            } else {
#pragma unroll
                for (int r = 0; r < 16; ++r) p[jt][r] = NEG;
            }
        }
        float mx = p[2][0];
#pragma unroll
        for (int jt = 0; jt < 5; ++jt)
#pragma unroll
            for (int r = 0; r < 16; ++r) mx = fmaxf(mx, p[jt][r]);
        mx = fmaxf(mx, __shfl_xor(mx, 32));
        float l = 0.f;
#pragma unroll
        for (int jt = 0; jt < 5; ++jt)
#pragma unroll
            for (int r = 0; r < 16; ++r) { p[jt][r] = __builtin_amdgcn_exp2f(p[jt][r] - mx); l += p[jt][r]; }
        l += __shfl_xor(l, 32);
        f32x16 o0 = {}, o1 = {};
        const ALAS unsigned char* vb = lds + V_OFF + (4 * hi + ((lane & 15) >> 2)) * 64 + ((lane >> 4) & 1) * 32 + (lane & 3) * 8;
#pragma unroll
        for (int jt = 0; jt < 5; ++jt) {
            const int key0 = i0 - 64 + 32 * jt;
            if (key0 >= 0 && key0 < L) {
                const ALAS unsigned char* vt = vb + (tb + jt) * 4096;
                u32x4 w0, w1;
                w0.x = cvtpk(p[jt][0], p[jt][1]); w0.y = cvtpk(p[jt][2], p[jt][3]); w0.z = cvtpk(p[jt][4], p[jt][5]); w0.w = cvtpk(p[jt][6], p[jt][7]);
                w1.x = cvtpk(p[jt][8], p[jt][9]); w1.y = cvtpk(p[jt][10], p[jt][11]); w1.z = cvtpk(p[jt][12], p[jt][13]); w1.w = cvtpk(p[jt][14], p[jt][15]);
                const bf16x8 pf0 = __builtin_bit_cast(bf16x8, w0), pf1 = __builtin_bit_cast(bf16x8, w1);
#define ATTA_VF(off) ({ const s16x4 lo_ = vtr(vt + (off)), hi_ = vtr(vt + (off) + 512); (bf16x8){lo_[0], lo_[1], lo_[2], lo_[3], hi_[0], hi_[1], hi_[2], hi_[3]}; })
                const bf16x8 v00 = ATTA_VF(0), v01 = ATTA_VF(1024), v10 = ATTA_VF(2048), v11 = ATTA_VF(2048 + 1024);
#undef ATTA_VF
                o0 = __builtin_amdgcn_mfma_f32_32x32x16_bf16(v00, pf0, o0, 0, 0, 0);
                o1 = __builtin_amdgcn_mfma_f32_32x32x16_bf16(v10, pf0, o1, 0, 0, 0);
                o0 = __builtin_amdgcn_mfma_f32_32x32x16_bf16(v01, pf1, o0, 0, 0, 0);
                o1 = __builtin_amdgcn_mfma_f32_32x32x16_bf16(v11, pf1, o1, 0, 0, 0);
            }
        }
        const float inv = 1.0f / l;
        float wc_ = inv, wp_ = 0.f, lse_new = mx + __builtin_amdgcn_logf(l);
        if (g > 0) {
            const float mm = fmaxf(lprev, lse_new), ep = __builtin_amdgcn_exp2f(lprev - mm), ec = __builtin_amdgcn_exp2f(lse_new - mm), den = ep + ec;
            wp_ = ep / den; wc_ = inv * (ec / den); lse_new = mm + __builtin_amdgcn_logf(den);
        }
        if (g < 2 && hi == 0) P.lse[(size_t)(b * 2048 + ((i0 + q) << dlog) + rres) * 16 + h] = lse_new;
#pragma unroll
        for (int db = 0; db < 2; ++db)
#pragma unroll
            for (int rr = 0; rr < 4; ++rr) {
                u32x2 wv;
                wv.x = cvtpk((db == 0 ? o0[4 * rr + 0] : o1[4 * rr + 0]) * wc_, (db == 0 ? o0[4 * rr + 1] : o1[4 * rr + 1]) * wc_);
                wv.y = cvtpk((db == 0 ? o0[4 * rr + 2] : o1[4 * rr + 2]) * wc_, (db == 0 ? o0[4 * rr + 3] : o1[4 * rr + 3]) * wc_);
                *(ALAS u32x2*)(stg + q * ST_ROW + (32 * db + 8 * rr + 4 * hi) * 2) = wv;
            }
        if (hi == 0) stw[q] = wp_;
        u32x4 pv[4];
#pragma unroll
        for (int i = 0; i < 4; ++i) pv[i] = prevo[i];
        bf16_t* const obase = P.O + (size_t)(b * 2048 + rres) * 1024 + h * 64 + (lane & 7) * 8;
        const int orow0 = i0 + (lane >> 3);
        asm volatile("s_waitcnt lgkmcnt(0)" ::: "memory"); __builtin_amdgcn_s_barrier(); asm volatile("" ::: "memory");
        if (k + 1 < 4) ATTA_ISSUE(k + 1);
#pragma unroll
        for (int i = 0; i < 4; ++i) {
            const int row = 8 * i + (lane >> 3);
            const u32x4 sv = *(const ALAS u32x4*)(stg + row * ST_ROW + (lane & 7) * 16);
            u32x4 ov = sv;
            if (g > 0) {
                const float wr_ = stw[row];
#pragma unroll
                for (int e = 0; e < 4; ++e) {
                    const float a0 = __uint_as_float(sv[e] << 16) + wr_ * __uint_as_float(pv[i][e] << 16);
                    const float a1 = __uint_as_float(sv[e] & 0xffff0000u) + wr_ * __uint_as_float(pv[i][e] & 0xffff0000u);
                    ov[e] = cvtpk(a0, a1);
                }
            }
            *(u32x4*)(obase + ((size_t)((orow0 + 8 * i) << dlog)) * 1024) = ov;
        }
    }
    asm volatile("s_waitcnt vmcnt(0) lgkmcnt(0)" ::: "memory"); __builtin_amdgcn_s_barrier(); asm volatile("" ::: "memory");
#undef ATTA_DECODE
#undef ATTA_ISSUE
}
}

constexpr int NWAVES = 8;
#ifndef MK_N_LAUNCHES
#define MK_N_LAUNCHES 1
#endif
constexpr int N_PHASES = 30;
constexpr int N_LAUNCHES = MK_N_LAUNCHES;
constexpr int BATCH = 8, SEQ = 2048, D = 1024, FF = 4096, M = BATCH * SEQ;
constexpr size_t MiB = 1u << 20;
constexpr size_t WS_CTL = 0, CTL_ZERO_BYTES = 1 * MiB;
constexpr size_t WS_TAB = 1 * MiB;
constexpr size_t WS_RSS = 2 * MiB;
constexpr size_t WS_LSE = 3 * MiB;
constexpr size_t WS_XB = 121 * MiB;
constexpr size_t WS_ACT = 153 * MiB, WS_QKV = WS_ACT, WS_O = 249 * MiB, WS_H = WS_ACT, WS_END = 281 * MiB;
constexpr int CW_BAR = 4096;
constexpr int RING_OFF = 0, RING_BYTES = 131072;
constexpr int LDSCTL_OFF = 139264, MISC_OFF = LDSCTL_OFF + 320;
constexpr int TB_OFF = LDSCTL_OFF + 1024;
constexpr int LDS_BYTES = 147456;

struct Args { const float* in[29]; float* out; unsigned char* ws; int ph_lo, ph_hi; };
struct LayerDesc { const float *anorm, *win, *wout, *mnorm, *wup, *wdown, *rpb, *qn, *kn; int kind, nin; size_t o_in, o_out, o_up, o_down; };
__device__ __forceinline__ LayerDesc get_layer(const Args& a, int L) {
    LayerDesc d; int base, wo;
    if (L == 0)      { base = 1;  wo = 3;  d.kind = 0; d.nin = 9216; d.o_in = 4 * MiB;  d.o_out = 22 * MiB;  d.o_up = 24 * MiB;  d.o_down = 32 * MiB; }
    else if (L == 1) { base = 7;  wo = 10; d.kind = 1; d.nin = 3072; d.o_in = 40 * MiB; d.o_out = 46 * MiB;  d.o_up = 48 * MiB;  d.o_down = 56 * MiB; }
    else if (L == 2) { base = 14; wo = 18; d.kind = 2; d.nin = 1536; d.o_in = 64 * MiB; d.o_out = 67 * MiB;  d.o_up = 69 * MiB;  d.o_down = 77 * MiB; }
    else             { base = 22; wo = 24; d.kind = 0; d.nin = 9216; d.o_in = 85 * MiB; d.o_out = 103 * MiB; d.o_up = 105 * MiB; d.o_down = 113 * MiB; }
    d.anorm = a.in[base]; d.win = a.in[base + 1]; d.wout = a.in[wo]; d.mnorm = a.in[wo + 1]; d.wup = a.in[wo + 2]; d.wdown = a.in[wo + 3];
    d.rpb = a.in[9]; d.qn = a.in[16]; d.kn = a.in[17];
    return d;
}

__device__ __forceinline__ float wave_sum(float v) {
#pragma unroll
    for (int o = 1; o < 64; o <<= 1) v += __shfl_xor(v, o);
    return v;
}
__device__ __forceinline__ void titem_load(const float* W, int N, const float* gain, int nblk, int item, int lane, f32x4 (&v)[8], float (&gk)[8]) {
    const int kb = item / nblk, nb = item - kb * nblk, k0 = 64 * kb, n0 = 32 * nb;
#pragma unroll
    for (int i = 0; i < 8; ++i) { const int kk = 8 * i + (lane >> 3), n4 = 4 * (lane & 7);
        v[i] = *(const GAS f32x4*)(W + (size_t)(k0 + kk) * N + n0 + n4); gk[i] = gain ? gain[k0 + kk] : 1.0f; }
}
__device__ __forceinline__ void titem_store(const f32x4 (&v)[8], const float (&gk)[8], int K, bf16* WT, bool perm, LAS float* scr, int nblk, int item, int lane) {
    const int kb = item / nblk, nb = item - kb * nblk, k0 = 64 * kb, n0 = 32 * nb;
#pragma unroll
    for (int i = 0; i < 8; ++i) { const int kk = 8 * i + (lane >> 3), n4 = 4 * (lane & 7);
        LAS float* s = scr + kk * 33 + n4; s[0] = v[i][0] * gk[i]; s[1] = v[i][1] * gk[i]; s[2] = v[i][2] * gk[i]; s[3] = v[i][3] * gk[i]; }
    LDS_WAIT(); asm volatile("" ::: "memory");
    const int c = lane & 7;
    const int nrow0 = perm ? ((n0 & ~255) | (((n0 >> 5) & 1) << 7) | (((n0 >> 6) & 3) << 5)) : n0;
#pragma unroll
    for (int j = 0; j < 4; ++j) { const int n = (lane >> 3) + 8 * j; const LAS float* s = scr + (8 * c) * 33 + n;
        v4u o; o.x = pk2(s[0 * 33], s[1 * 33]); o.y = pk2(s[2 * 33], s[3 * 33]); o.z = pk2(s[4 * 33], s[5 * 33]); o.w = pk2(s[6 * 33], s[7 * 33]);
        *(GAS v4u*)(WT + (size_t)(nrow0 + n) * K + k0 + 8 * c) = o; }
    LDS_WAIT(); asm volatile("" ::: "memory");
}
__global__ void __launch_bounds__(NWAVES * 64, 2) mk_fwd(Args args) {
    extern __shared__ __attribute__((aligned(16))) unsigned char lds[];
    LAS unsigned char* const L3 = (LAS unsigned char*)lds;
    volatile LAS unsigned* const MISC = (volatile LAS unsigned*)(L3 + MISC_OFF);
    const int tid = threadIdx.x, lane = tid & 63, wave = __builtin_amdgcn_readfirstlane(tid >> 6);
    const int G = gridDim.x; const int bx = blockIdx.x; const int vcu = (G % 8 == 0) ? (bx % 8) * (G / 8) + bx / 8 : bx;
    unsigned char* const ws = args.ws;
    gu32* const ctl = (gu32*)(ws + WS_CTL);
    for (int u = tid; u < (LDS_BYTES - LDSCTL_OFF) / 4; u += NWAVES * 64) ((LAS unsigned*)(L3 + LDSCTL_OFF))[u] = 0u;
    __syncthreads();
    XcdBarrier bar; bar.bar = (unsigned*)(ctl + CW_BAR); bar.x = 0; bar.st = nullptr;
    if (N_LAUNCHES == 1) bar = xcd_barrier_post((unsigned*)(ctl + CW_BAR), MISC + 8);
    const int lo = args.ph_lo, hi = args.ph_hi;
    int ph = 0;
#ifndef PROBE_DUP_MASK
#define PROBE_DUP_MASK 0ull
#endif
#define PH_ON() (lo <= ph && ph < hi)
#ifndef PROBE_REPS
#define PROBE_REPS 2
#endif
#define PH_REP() (((PROBE_DUP_MASK >> ph) & 1ull) ? PROBE_REPS : 1)
#define PH_END() do { if (ph + 1 < hi) { if (N_LAUNCHES == 1) xcd_barrier(bar); } ++ph; } while (0)

#define tabs ((float*)(ws + WS_TAB))
#define invA (tabs)
#define invC (tabs + 32)
#define rss ((float*)(ws + WS_RSS))
#define lse ((float*)(ws + WS_LSE))
#define XB ((bf16*)(ws + WS_XB))
#define QKV ((bf16*)(ws + WS_QKV))
#define OB ((bf16*)(ws + WS_O))
#define HB ((bf16*)(ws + WS_H))
    const int gw = vcu * NWAVES + wave, NGW = G * NWAVES;

    if (PH_ON()) for (int rep_ = 0; rep_ < PH_REP(); ++rep_) {
        LAS float* scr = (LAS float*)(L3 + RING_OFF + wave * 16384);
        int rot = 0;
        for (int mi = 0; mi < 16; ++mi) {
            const LayerDesc d = get_layer(args, mi >> 2); const int j = mi & 3;
            const float* W = j == 0 ? d.win : j == 1 ? d.wout : j == 2 ? d.wup : d.wdown;
            const int K = j == 3 ? FF : D, N = j == 0 ? d.nin : j == 2 ? FF : D;
            const float* gain = j == 0 ? d.anorm : j == 2 ? d.mnorm : nullptr;
            bf16* WT = (bf16*)(ws + (j == 0 ? d.o_in : j == 1 ? d.o_out : j == 2 ? d.o_up : d.o_down));
            const int nitems = (K / 64) * (N / 32);
            int it0 = (gw - rot) % NGW; if (it0 < 0) it0 += NGW;
            const int nblk = N / 32;
            f32x4 cv[8], nv[8]; float cg[8], ng[8];
            int it = it0;
            if (it < nitems) titem_load(W, N, gain, nblk, it, lane, cv, cg);
            while (it < nitems) {
                const int nx = it + NGW;
                if (nx < nitems) titem_load(W, N, gain, nblk, nx, lane, nv, ng);
                titem_store(cv, cg, K, WT, j == 0, scr, nblk, it, lane);
#pragma unroll
                for (int i = 0; i < 8; ++i) { cv[i] = nv[i]; cg[i] = ng[i]; }
                it = nx;
            }
            rot = (rot + nitems) % NGW;
        }
        const float* x = args.in[0];
        { f32x4 v[4], vn[4];
          if (gw < M) { const GAS f32x4* xr = (const GAS f32x4*)(x + (size_t)gw * D) + lane;
#pragma unroll
              for (int j = 0; j < 4; ++j) v[j] = xr[64 * j]; }
          for (int m = gw; m < M; m += NGW) {
            if (m + NGW < M) { const GAS f32x4* xr = (const GAS f32x4*)(x + (size_t)(m + NGW) * D) + lane;
#pragma unroll
                for (int j = 0; j < 4; ++j) vn[j] = xr[64 * j]; }
            float s = 0.f;
            GAS unsigned long long* o8 = (GAS unsigned long long*)(XB + (size_t)m * D) + lane;
#pragma unroll
            for (int j = 0; j < 4; ++j) { const unsigned lo = pk2(v[j].x, v[j].y), hi2 = pk2(v[j].z, v[j].w); o8[64 * j] = (unsigned long long)lo | ((unsigned long long)hi2 << 32);
                const float r0 = __uint_as_float(lo << 16), r1 = __uint_as_float(lo & 0xffff0000u), r2 = __uint_as_float(hi2 << 16), r3 = __uint_as_float(hi2 & 0xffff0000u);
                s += (r0 * r0 + r1 * r1) + (r2 * r2 + r3 * r3); }
            s = wave_sum(s);
            if (lane < 4) rss[(size_t)m * 4 + lane] = (lane == 0) ? s : 0.f;
#pragma unroll
            for (int j = 0; j < 4; ++j) v[j] = vn[j];
          } }
        if (bx == 0 && tid < 64) {
            const int i = tid & 31;
            if (tid < 32) invA[i] = 1.0f / powf(10000.0f, (float)(2 * i) / 64.0f);
            else invC[i] = 1.0f / powf(10000.0f, (float)(2 * (i & 15)) / 32.0f);
        }
    }
    PH_END();

    for (int L = 0; L < 4; ++L) {
        const int kind = (L == 1) ? 1 : (L == 2) ? 2 : 0;
#define LD() const LayerDesc d = get_layer(args, L)
        if (kind == 0) {
            for (int g = 0; g < 3; ++g) {
                if (PH_ON()) for (int rep_ = 0; rep_ < PH_REP(); ++rep_) {
                    LD(); pg8::Gemm gm{XB, (const bf16*)(ws + d.o_in) + (size_t)g * 3072 * D, M, 3072, D}; pg8::StaticOrder S; S.init(M, 3072, G, bx);
                    pg8::TablePre TP; TP.load((LAS float*)(L3 + TB_OFF), S, rss, invA, nullptr, nullptr);
                    pg8::EpiQKV<0> E{QKV, 3072, (const LAS float*)(L3 + TB_OFF)};
                    pg8::gemm_phase<pg8::EpiQKV<0>, pg8::StaticOrder, true, true, pg8::TablePre>(L3 + RING_OFF, gm, S, E, TP);
                }
                PH_END();
                if (PH_ON()) for (int rep_ = 0; rep_ < PH_REP(); ++rep_) {
                    atta::Params P{QKV, OB, lse, g == 0 ? 0 : (g == 1 ? 2 : 4), g};
                    atta::phase(P, L3 + RING_OFF, vcu, lane);
                }
                PH_END();
            }
        } else if (kind == 1) {
            if (PH_ON()) for (int rep_ = 0; rep_ < PH_REP(); ++rep_) {
                LD(); pg8::Gemm gm{XB, (const bf16*)(ws + d.o_in), M, 3072, D}; pg8::StaticOrder S; S.init(M, 3072, G, bx);
                pg8::TablePre TP; TP.load((LAS float*)(L3 + TB_OFF), S, rss, nullptr, nullptr, nullptr);
                pg8::EpiQKV<1> E{QKV, 3072, (const LAS float*)(L3 + TB_OFF)};
                pg8::gemm_phase<pg8::EpiQKV<1>, pg8::StaticOrder, true, true, pg8::TablePre>(L3 + RING_OFF, gm, S, E, TP);
            }
            PH_END();
            if (PH_ON()) for (int rep_ = 0; rep_ < PH_REP(); ++rep_) {
                att::AttnP P{QKV, QKV + 1024, QKV + 2048, 3072, OB, lse, args.in[9], 0, 0};
                att::attn_phase<1>(P, L3 + RING_OFF, vcu, wave, lane);
            }
            PH_END();
        } else {
            if (PH_ON()) for (int rep_ = 0; rep_ < PH_REP(); ++rep_) {
                LD(); pg8::Gemm gm{XB, (const bf16*)(ws + d.o_in), M, 1536, D}; pg8::StaticOrder S; S.init(M, 1536, G, bx);
                pg8::TablePre TP; TP.load((LAS float*)(L3 + TB_OFF), S, rss, invC, args.in[16], args.in[17]);
                pg8::EpiQKV<2> E{QKV, 1536, (const LAS float*)(L3 + TB_OFF)};
                pg8::gemm_phase<pg8::EpiQKV<2>, pg8::StaticOrder, true, true, pg8::TablePre>(L3 + RING_OFF, gm, S, E, TP);
            }
            PH_END();
            if (PH_ON()) for (int rep_ = 0; rep_ < PH_REP(); ++rep_) {
                const attc::AttnTensors AT{(const attc::bf16*)QKV, (const attc::bf16*)(QKV + 1024), (const attc::bf16*)(QKV + 1280), (attc::bf16*)OB};
                attc::attn_phase<8>((char*)lds + RING_OFF, AT, vcu);
            }
            PH_END();
        }
        if (PH_ON()) for (int rep_ = 0; rep_ < PH_REP(); ++rep_) {
            LD(); pg8::Gemm gm{OB, (const bf16*)(ws + d.o_out), M, D, D}; pg8::StaticOrder S; S.init(M, D, G, bx);
            pg8::EpiRes E{XB, rss};
            pg8::gemm_phase<pg8::EpiRes, pg8::StaticOrder, false, true>(L3 + RING_OFF, gm, S, E);
        }
        PH_END();
        if (PH_ON()) for (int rep_ = 0; rep_ < PH_REP(); ++rep_) {
            LD(); pg8::Gemm gm{XB, (const bf16*)(ws + d.o_up), M, FF, D}; pg8::StaticOrder S; S.init(M, FF, G, bx);
            pg8::TablePre TP; TP.load((LAS float*)(L3 + TB_OFF), S, rss, nullptr, nullptr, nullptr);
            pg8::EpiUp E{HB, FF, (const LAS float*)(L3 + TB_OFF)};
            pg8::gemm_phase<pg8::EpiUp, pg8::StaticOrder, true, true, pg8::TablePre>(L3 + RING_OFF, gm, S, E, TP);
        }
        PH_END();
        if (PH_ON()) for (int rep_ = 0; rep_ < PH_REP(); ++rep_) {
            LD(); pg8::Gemm gm{HB, (const bf16*)(ws + d.o_down), M, D, FF}; pg8::StaticOrder S; S.init(M, D, G, bx);
            pg8::EpiRes E{XB, rss};
            pg8::gemm_phase<pg8::EpiRes, pg8::StaticOrder, false, true>(L3 + RING_OFF, gm, S, E);
        }
        PH_END();
    }
    if (PH_ON()) for (int rep_ = 0; rep_ < PH_REP(); ++rep_) {
        const float* gf = args.in[28];
        for (int m = gw; m < M; m += NGW) {
            const float rstd = pg8::row_rstd(rss, m);
            const GAS unsigned long long* xr = (const GAS unsigned long long*)(XB + (size_t)m * D) + lane; GAS f32x4* orow = (GAS f32x4*)(args.out + (size_t)m * D) + lane; const GAS f32x4* gr = (const GAS f32x4*)gf + lane;
#pragma unroll
            for (int j = 0; j < 4; ++j) { const unsigned long long xv = xr[64 * j]; const unsigned lo = (unsigned)xv, hi2 = (unsigned)(xv >> 32); const f32x4 gg = gr[64 * j];
                f32x4 v; v.x = __uint_as_float(lo << 16); v.y = __uint_as_float(lo & 0xffff0000u); v.z = __uint_as_float(hi2 << 16); v.w = __uint_as_float(hi2 & 0xffff0000u);
                orow[64 * j] = v * rstd * gg; }
        }
    }
#undef PH_ON
#undef PH_END
#undef LD
}

extern "C" void kernel_launch(void* const* d_in, const int* in_sizes, int n_in, void* d_out, int out_size, void* d_ws, size_t ws_size, hipStream_t stream) {
    static int grid = 0;
    if (grid == 0) {
        if (n_in != 29 || in_sizes[0] != M * D || out_size != M * D || ws_size < WS_END) { fprintf(stderr, "kernel_launch: unexpected shapes / workspace (n_in %d, ws %zu); nothing launched\n", n_in, ws_size); grid = -1; return; }
        int dev = 0, cus = 0, per_cu = 0;
        if (hipGetDevice(&dev) != hipSuccess || hipDeviceGetAttribute(&cus, hipDeviceAttributeMultiprocessorCount, dev) != hipSuccess) { grid = -1; return; }
        if (hipFuncSetAttribute((const void*)mk_fwd, hipFuncAttributeMaxDynamicSharedMemorySize, LDS_BYTES) != hipSuccess) { fprintf(stderr, "kernel_launch: hipFuncSetAttribute failed\n"); grid = -1; return; }
        if (hipOccupancyMaxActiveBlocksPerMultiprocessor(&per_cu, (const void*)mk_fwd, NWAVES * 64, LDS_BYTES) != hipSuccess || per_cu < 1) fprintf(stderr, "kernel_launch: occupancy query reports %d\n", per_cu);
        (void)hipGetLastError();
        if (cus != 256) { fprintf(stderr, "kernel_launch: built for a 256-CU device, found %d; nothing launched\n", cus); grid = -1; return; }
        grid = 256;
    }
    if (grid < 0) return;
    if (hipMemsetAsync((char*)d_ws + WS_CTL, 0, CTL_ZERO_BYTES, stream) != hipSuccess) return;
    Args a{};
    for (int i = 0; i < 29; ++i) a.in[i] = (const float*)d_in[i];
    a.out = (float*)d_out; a.ws = (unsigned char*)d_ws;
    if (N_LAUNCHES == 1) { a.ph_lo = 0; a.ph_hi = N_PHASES; hipLaunchKernelGGL(mk_fwd, dim3(grid), dim3(NWAVES * 64), LDS_BYTES, stream, a); }
    else for (int p = 0; p < N_PHASES; ++p) { a.ph_lo = p; a.ph_hi = p + 1; hipLaunchKernelGGL(mk_fwd, dim3(grid), dim3(NWAVES * 64), LDS_BYTES, stream, a); }
}
```

```cpp
#include <hip/hip_runtime.h>
#include <cstdio>
#include <cstdint>
namespace pg8 {
#define PG8_LAS __attribute__((address_space(3)))
typedef unsigned short bf16_t;
typedef short bf16x8 __attribute__((ext_vector_type(8)));
typedef float f32x4 __attribute__((ext_vector_type(4)));
typedef unsigned u32x4 __attribute__((ext_vector_type(4)));
constexpr int BM = 256, BK = 64, HALF = 128, HTB = HALF * BK * 2  , STAGE_BYTES = 8 * HTB, NXCD = 8, WGM = 8;

__host__ __device__ __forceinline__ int lds_byte(int r, int c) { const int st = (r >> 4) * 2 + (c >> 5), rr = r & 15, cc = c & 31, ob = rr * 64 + cc * 2; return st * 1024 + (ob ^ (((ob >> 9) & 1) << 5)); }
__host__ __device__ __forceinline__ void stage_rc(int b, int& R, int& C) { const int st = b / 1024, sb = b % 1024, swz = sb ^ (((sb >> 9) & 1) << 5); R = (st >> 1) * 16 + swz / 64; C = (st & 1) * 32 + (swz % 64) / 2; }
__host__ __device__ __forceinline__ int perm32(int rho) { const int n = rho >> 4, i = rho & 15; return 8 * (i >> 2) + 4 * n + (i & 3); }

struct Unit { int pm, pn; };
struct Gemm { const bf16_t* A; const bf16_t* Bt; int M, N, K; };

struct StaticOrder {
    int nM, nN, nwg, G, c;
    __host__ __device__ void init(int M, int N, int G_, int c_) { nM = M / BM; nN = N / BM; nwg = nM * nN; G = G_; c = c_; }
    __host__ __device__ bool next(int i, Unit& u) const {
        const long L = (long)i * G + c; if (L >= nwg) return false;
        int wgid = (int)L; { const int q = nwg / NXCD, r = nwg % NXCD, xcd = wgid % NXCD, off = wgid / NXCD; wgid = (xcd < r ? xcd * (q + 1) : r * (q + 1) + (xcd - r) * q) + off; }
        const int nig = WGM * nN, gid = wgid / nig, fm = gid * WGM, gsz = (nM - fm) < WGM ? (nM - fm) : WGM;
        u.pm = fm + ((wgid % nig) % gsz); u.pn = (wgid % nig) / gsz; return true;
    }
    __device__ __forceinline__ void a_ready(const Unit&) const {}
    __device__ __forceinline__ void done(const Unit&) const {}
};


__device__ __forceinline__ unsigned cvt_pk_bf16(float lo, float hi) { unsigned r; asm volatile("v_cvt_pk_bf16_f32 %0, %1, %2" : "=v"(r) : "v"(lo), "v"(hi)); return r; }
typedef unsigned u32x2 __attribute__((ext_vector_type(2)));
constexpr float QSCALE = 0.125f * 1.4426950408889634f;
constexpr float RMS_EPS = 1e-6f;
__device__ __forceinline__ float rstd_of(const f32x4 p) { return __builtin_amdgcn_rsqf(((p[0] + p[1]) + (p[2] + p[3])) * (1.0f / 1024.0f) + RMS_EPS); }
__device__ __forceinline__ float row_rstd(const float* rss, int row) { return rstd_of(*(const f32x4*)(rss + (size_t)row * 4)); }
__device__ __forceinline__ void sincos_rev(float a, float& s, float& c) {
    const float k = __builtin_rintf(a * 0.15915494309189535f);
    float r = __builtin_fmaf(-k, 6.28318548202514648f, a); r = __builtin_fmaf(-k, -1.7484555e-7f, r);
    const float x = r * 0.15915494309189535f;
    s = __builtin_amdgcn_sinf(x); c = __builtin_amdgcn_cosf(x);
}
template <int KIND> struct EpiQKV {
    static constexpr bool PERM = true, AFTER_DRAIN = false;
    bf16_t* O; int ldc; const PG8_LAS float* tb;
    __device__ __forceinline__ void operator()(const f32x4 (&acc)[2][2][4][2], const Unit& u, int wr, int wc, int fr, int fq, int ui) const {
        const int tcol = u.pn * BM;
        int sec;
        if (KIND == 2) sec = tcol < 1024 ? 0 : (tcol == 1024 ? 1 : 2); else sec = tcol >> 10;
        const int row0 = u.pm * BM + wr * 64 + fr;
        const int lc0 = tcol + 64 * wc + 8 * fq;
        const bool do_rope = (KIND != 1) && sec < 2;
        const bool do_hn = (KIND == 2) && sec < 2;
        const float qs = (sec == 0) ? QSCALE : 1.0f;
        const PG8_LAS float* rt = tb + ui * 256 + wr * 64 + fr;
        f32x4 iv[2] = {(f32x4){0.f, 0.f, 0.f, 0.f}, (f32x4){0.f, 0.f, 0.f, 0.f}};
        if (do_rope) { iv[0] = *(const PG8_LAS f32x4*)(tb + 1024 + 8 * fq); iv[1] = *(const PG8_LAS f32x4*)(tb + 1024 + 8 * fq + 4); }
        f32x4 g[2][2];
#pragma unroll
        for (int bj = 0; bj < 2; ++bj)
#pragma unroll
            for (int n = 0; n < 2; ++n) g[bj][n] = (f32x4){1.f, 1.f, 1.f, 1.f};
        if (do_hn) { const PG8_LAS float* gp = tb + 1056 + (sec == 0 ? 0 : 64);
#pragma unroll
            for (int bj = 0; bj < 2; ++bj)
#pragma unroll
                for (int n = 0; n < 2; ++n) g[bj][n] = *(const PG8_LAS f32x4*)(gp + 32 * bj + 8 * fq + 4 * n); }
#pragma unroll
        for (int ai = 0; ai < 2; ++ai)
#pragma unroll
            for (int m = 0; m < 4; ++m) {
                const int row = row0 + ai * HALF + m * 16;
                const float rstd = rt[ai * HALF + m * 16];
                f32x4 v[2][2];
#pragma unroll
                for (int bj = 0; bj < 2; ++bj)
#pragma unroll
                    for (int n = 0; n < 2; ++n) v[bj][n] = acc[ai][bj][m][n] * rstd;
                if (do_hn) {
                    float ss = 0.f;
#pragma unroll
                    for (int bj = 0; bj < 2; ++bj)
#pragma unroll
                        for (int n = 0; n < 2; ++n) { const f32x4 x = v[bj][n]; ss += (x[0] * x[0] + x[1] * x[1]) + (x[2] * x[2] + x[3] * x[3]); }
                    ss += __shfl_xor(ss, 16); ss += __shfl_xor(ss, 32);
                    const float r2 = __builtin_amdgcn_rsqf(ss * (1.0f / 64.0f) + RMS_EPS);
#pragma unroll
                    for (int bj = 0; bj < 2; ++bj)
#pragma unroll
                        for (int n = 0; n < 2; ++n) v[bj][n] = v[bj][n] * r2 * g[bj][n];
                }
                if (do_rope) {
                    const int t = row & 2047;
                    const float posf = (float)(KIND == 2 ? (fq < 2 ? (t >> 6) : (t & 63)) : t);
#pragma unroll
                    for (int n = 0; n < 2; ++n)
#pragma unroll
                        for (int e = 0; e < 4; ++e) {
                            float s, c; sincos_rev(posf * iv[n][e], s, c);
                            const float x1 = v[0][n][e], x2 = v[1][n][e];
                            v[0][n][e] = x1 * c - x2 * s; v[1][n][e] = x2 * c + x1 * s;
                        }
                }
                bf16_t* rowp = O + (size_t)row * ldc + lc0;
#pragma unroll
                for (int bj = 0; bj < 2; ++bj) {
                    const f32x4 v0 = v[bj][0] * qs, v1 = v[bj][1] * qs;
                    u32x4 w; w.x = cvt_pk_bf16(v0[0], v0[1]); w.y = cvt_pk_bf16(v0[2], v0[3]); w.z = cvt_pk_bf16(v1[0], v1[1]); w.w = cvt_pk_bf16(v1[2], v1[3]);
                    *(u32x4*)(rowp + 32 * bj) = w;
                }
            }
    }
};
struct TablePre {
    PG8_LAS float* tb; int tid; f32x4 p[4]; bool ok[4]; float sv; int sidx;
    template <class Sched> __device__ __forceinline__ void load(PG8_LAS float* tb_, const Sched& S, const float* rss, const float* inv, const float* qg, const float* kg) {
        int tid_ = threadIdx.x; asm volatile("" : "+v"(tid_));
        tb = tb_; tid = tid_; sidx = -1; sv = 0.f;
        Unit u;
#pragma unroll
        for (int i = 0; i < 4; ++i) { ok[i] = false; p[i] = (f32x4){0.f, 0.f, 0.f, 0.f}; }
        if (tid_ < 256) {
#pragma unroll
            for (int i = 0; i < 4; ++i) { ok[i] = S.next(i, u); if (ok[i]) p[i] = *(const f32x4*)(rss + (size_t)(u.pm * BM + tid_) * 4); }
        } else if (tid_ < 288) { if (inv) { sv = inv[tid_ - 256]; sidx = 1024 + tid_ - 256; } }
        else if (tid_ < 352) { if (qg) { sv = qg[tid_ - 288]; sidx = 1056 + tid_ - 288; } }
        else if (tid_ < 416) { if (kg) { sv = kg[tid_ - 352]; sidx = 1120 + tid_ - 352; } }
    }
    __device__ __forceinline__ void operator()() const {
#pragma unroll
        for (int i = 0; i < 4; ++i) if (ok[i]) tb[i * 256 + tid] = rstd_of(p[i]);
        if (sidx >= 0) tb[sidx] = sv;
        asm volatile("s_waitcnt lgkmcnt(0)" ::: "memory"); __builtin_amdgcn_s_barrier(); asm volatile("" ::: "memory");
    }
};
struct EpiRes {
    static constexpr bool PERM = false, AFTER_DRAIN = true;
    bf16_t* xb; float* rss;
    __device__ __forceinline__ void fused(const f32x4 (&acc)[2][2][4][2], const Unit& u, int wr, int wc, int fr, int fq, PG8_LAS unsigned char* lds, int wid, int lane) const {
        const int row0 = u.pm * BM + wr * 64 + fr, col0 = u.pn * BM + wc * 32 + 4 * fq;
        PG8_LAS float* P = (PG8_LAS float*)lds;
        u32x2 xi[2][4][2][2];
#pragma unroll
        for (int ai = 0; ai < 2; ++ai)
#pragma unroll
            for (int m = 0; m < 4; ++m)
#pragma unroll
                for (int bj = 0; bj < 2; ++bj)
#pragma unroll
                    for (int n = 0; n < 2; ++n) xi[ai][m][bj][n] = *(const u32x2*)(xb + (size_t)(row0 + ai * HALF + m * 16) * 1024 + col0 + bj * HALF + n * 16);
#pragma unroll
        for (int ai = 0; ai < 2; ++ai)
#pragma unroll
            for (int m = 0; m < 4; ++m) {
                const int row = row0 + ai * HALF + m * 16; float ss = 0.f;
#pragma unroll
                for (int bj = 0; bj < 2; ++bj)
#pragma unroll
                    for (int n = 0; n < 2; ++n) {
                        const size_t off = (size_t)row * 1024 + col0 + bj * HALF + n * 16;
                        const u32x2 xo = xi[ai][m][bj][n]; const f32x4 a = acc[ai][bj][m][n];
                        const float x0 = __uint_as_float(xo.x << 16) + a[0], x1 = __uint_as_float(xo.x & 0xffff0000u) + a[1], x2 = __uint_as_float(xo.y << 16) + a[2], x3 = __uint_as_float(xo.y & 0xffff0000u) + a[3];
                        u32x2 w; w.x = cvt_pk_bf16(x0, x1); w.y = cvt_pk_bf16(x2, x3);
                        *(u32x2*)(xb + off) = w;
                        const float r0 = __uint_as_float(w.x << 16), r1 = __uint_as_float(w.x & 0xffff0000u), r2 = __uint_as_float(w.y << 16), r3 = __uint_as_float(w.y & 0xffff0000u);
                        ss += (r0 * r0 + r1 * r1) + (r2 * r2 + r3 * r3);
                    }
                ss += __shfl_xor(ss, 16); ss += __shfl_xor(ss, 32);
                if (fq == 0) P[(ai * HALF + wr * 64 + m * 16 + fr) * 4 + wc] = ss;
            }
        asm volatile("s_waitcnt lgkmcnt(0)" ::: "memory"); __builtin_amdgcn_s_barrier(); asm volatile("" ::: "memory");
        const int tid = wid * 64 + lane;
        if (tid < 256) { const f32x4 p = *(const PG8_LAS f32x4*)(P + tid * 4); rss[(size_t)(u.pm * BM + tid) * 4 + u.pn] = (p[0] + p[1]) + (p[2] + p[3]); }
        asm volatile("s_waitcnt lgkmcnt(0)" ::: "memory"); __builtin_amdgcn_s_barrier(); asm volatile("" ::: "memory");
    }
};
struct EpiUp {
    static constexpr bool PERM = true, AFTER_DRAIN = false;
    bf16_t* O; int ldc; const PG8_LAS float* tb;
    __device__ __forceinline__ void operator()(const f32x4 (&acc)[2][2][4][2], const Unit& u, int wr, int wc, int fr, int fq, int ui) const {
        const int row0 = u.pm * BM + wr * 64 + fr, col0 = u.pn * BM + wc * 32 + 8 * fq;
        const PG8_LAS float* rt = tb + ui * 256 + wr * 64 + fr;
#pragma unroll
        for (int ai = 0; ai < 2; ++ai)
#pragma unroll
            for (int m = 0; m < 4; ++m) {
                const int row = row0 + ai * HALF + m * 16;
                const float rstd = rt[ai * HALF + m * 16];
                bf16_t* rowp = O + (size_t)row * ldc + col0;
#pragma unroll
                for (int bj = 0; bj < 2; ++bj) {
                    f32x4 v0 = acc[ai][bj][m][0] * rstd, v1 = acc[ai][bj][m][1] * rstd;
#pragma unroll
                    for (int e = 0; e < 4; ++e) { const float a = v0[e] > 0.f ? v0[e] : 0.f, b = v1[e] > 0.f ? v1[e] : 0.f; v0[e] = a * a; v1[e] = b * b; }
                    u32x4 w; w.x = cvt_pk_bf16(v0[0], v0[1]); w.y = cvt_pk_bf16(v0[2], v0[3]); w.z = cvt_pk_bf16(v1[0], v1[1]); w.w = cvt_pk_bf16(v1[2], v1[3]);
                    *(u32x4*)(rowp + bj * HALF) = w;
                }
            }
    }
};

struct NoPre { __device__ __forceinline__ void operator()() const {} };
template <class Epi, class Sched, bool ALIGN_EPI = false, bool SP2 = false, class Pre = NoPre>
__device__ __forceinline__ void gemm_phase(PG8_LAS unsigned char* lds, const Gemm g, const Sched& S, const Epi& E, const Pre& pre = Pre()) {
    int tid_ = threadIdx.x; asm volatile("" : "+v"(tid_));
    const int tid = tid_, wid = __builtin_amdgcn_readfirstlane(tid >> 6), lane = tid & 63, wr = wid >> 2, wc = wid & 3, fr = lane & 15, fq = lane >> 4;
    const int K = g.K, nt = K / BK;
    unsigned voffA[2], voffB[2];
#pragma unroll
    for (int i = 0; i < 2; ++i) { int R, C; stage_rc(tid * 16 + i * 8192, R, C); const int Rb = Epi::PERM ? ((R & ~31) + perm32(R & 31)) : R;
        voffA[i] = (unsigned)(R * K + C) * 2u; voffB[i] = (unsigned)(Rb * K + C) * 2u; }
    const size_t kstep = (size_t)(BK * 2);
    const size_t hstep = (size_t)HALF * K * 2;
    const size_t tstep = 2 * hstep;
    const unsigned ldsw = (unsigned)wid * 1024u;
    const int aoff = lds_byte(wr * 64 + fr, fq * 8), boff = lds_byte(wc * 32 + fr, fq * 8);
#define PG8_SA(b, h) (((b) * 2 + (h)) * HTB)
#define PG8_SB(b, h) ((4 + (b) * 2 + (h)) * HTB)
#define PG8_STAGE(bufoff, gbase, voff) do { _Pragma("unroll") for (int _i = 0; _i < 2; ++_i) \
        __builtin_amdgcn_global_load_lds((const unsigned*)((const char*)(gbase) + (voff)[_i]), (PG8_LAS unsigned*)(lds + (bufoff) + ldsw + _i * 8192), 16, 0, 0); } while (0)
#define PG8_LDA(dst, b, h) do { _Pragma("unroll") for (int m = 0; m < 4; ++m) _Pragma("unroll") for (int k = 0; k < 2; ++k) dst[m][k] = *(const PG8_LAS bf16x8*)(lds + PG8_SA(b, h) + aoff + m * 2048 + k * 1024); } while (0)
#define PG8_LDB(dst, b, h) do { _Pragma("unroll") for (int n = 0; n < 2; ++n) _Pragma("unroll") for (int k = 0; k < 2; ++k) dst[n][k] = *(const PG8_LAS bf16x8*)(lds + PG8_SB(b, h) + boff + n * 2048 + k * 1024); } while (0)
#define PG8_MMA(ai, bj, At, Bt) do { __builtin_amdgcn_s_setprio(1); _Pragma("unroll") for (int m = 0; m < 4; ++m) _Pragma("unroll") for (int n = 0; n < 2; ++n) _Pragma("unroll") for (int k = 0; k < 2; ++k) \
        acc[ai][bj][m][n] = __builtin_amdgcn_mfma_f32_16x16x32_bf16(Bt[n][k], At[m][k], acc[ai][bj][m][n], 0, 0, 0); __builtin_amdgcn_s_setprio(0); } while (0)
#define PG8_WAIT_V(n) asm volatile("s_waitcnt vmcnt(" #n ")" ::: "memory")
#define PG8_WAIT_L(n) asm volatile("s_waitcnt lgkmcnt(" #n ")" ::: "memory")
#define PG8_BAR __builtin_amdgcn_s_barrier()
#define PG8_SCHED __builtin_amdgcn_sched_barrier(0)
    Unit cur, nxt; int ui = 0;
    if (!S.next(0, cur)) return;
    f32x4 acc[2][2][4][2];
#pragma unroll
    for (int a = 0; a < 2; ++a)
#pragma unroll
        for (int b = 0; b < 2; ++b)
#pragma unroll
            for (int m = 0; m < 4; ++m)
#pragma unroll
                for (int n = 0; n < 2; ++n) acc[a][b][m][n] = (f32x4){0.f, 0.f, 0.f, 0.f};
    bf16x8 At[4][2], B0[2][2], B1[2][2];
    const char* cA = (const char*)g.A + (size_t)cur.pm * tstep; const char* cB = (const char*)g.Bt + (size_t)cur.pn * tstep;
    S.a_ready(cur);
    if constexpr (SP2) {
        PG8_STAGE(PG8_SB(0, 0), cB, voffB); PG8_STAGE(PG8_SB(0, 1), cB + hstep, voffB); PG8_STAGE(PG8_SA(0, 0), cA, voffA); PG8_STAGE(PG8_SA(0, 1), cA + hstep, voffA);
        pre();
        if (wr == 1) PG8_BAR;
        PG8_WAIT_V(2); PG8_BAR;
        PG8_STAGE(PG8_SB(1, 0), cB + kstep, voffB); PG8_STAGE(PG8_SA(1, 0), cA + kstep, voffA); PG8_STAGE(PG8_SB(1, 1), cB + hstep + kstep, voffB);
        PG8_WAIT_V(6); PG8_BAR;
    } else {
        PG8_STAGE(PG8_SB(0, 0), cB, voffB); PG8_STAGE(PG8_SA(0, 0), cA, voffA); PG8_STAGE(PG8_SB(0, 1), cB + hstep, voffB); PG8_STAGE(PG8_SA(0, 1), cA + hstep, voffA);
        if (wr == 1) PG8_BAR;
        PG8_WAIT_V(4); PG8_BAR;
        PG8_STAGE(PG8_SB(1, 0), cB + kstep, voffB); PG8_STAGE(PG8_SA(1, 0), cA + kstep, voffA); PG8_STAGE(PG8_SB(1, 1), cB + hstep + kstep, voffB);
        PG8_WAIT_V(6); PG8_BAR;
    }
    for (;;) {
        const bool has_next = S.next(ui + 1, nxt);
        const char* nA = has_next ? (const char*)g.A + (size_t)nxt.pm * tstep : cA; const char* nB = has_next ? (const char*)g.Bt + (size_t)nxt.pn * tstep : cB;
        for (int t = 0; t < nt; t += 2) {
            const bool last = (t == nt - 2);
            const char* a1 = cA + (size_t)(t + 1) * kstep;
            const char* a2 = last ? nA : cA + (size_t)(t + 2) * kstep; const char* b2 = last ? nB : cB + (size_t)(t + 2) * kstep;
            const char* a3 = a2 + kstep; const char* b3 = b2 + kstep;
            if (last && has_next) S.a_ready(nxt);
            if constexpr (SP2) {
            PG8_LDB(B0, 0, 0); PG8_LDB(B1, 0, 1); PG8_SCHED; PG8_LDA(At, 0, 0); PG8_STAGE(PG8_SA(1, 1), a1 + hstep, voffA);
            PG8_WAIT_V(8); PG8_WAIT_L(0); PG8_BAR; PG8_MMA(0, 0, At, B0); PG8_MMA(0, 1, At, B1); PG8_BAR; PG8_SCHED;
            PG8_LDA(At, 0, 1); PG8_STAGE(PG8_SB(0, 0), b2, voffB); PG8_STAGE(PG8_SB(0, 1), b2 + hstep, voffB); PG8_STAGE(PG8_SA(0, 0), a2, voffA);
            PG8_WAIT_V(8); PG8_WAIT_L(0); PG8_BAR; PG8_MMA(1, 0, At, B0); PG8_MMA(1, 1, At, B1); PG8_BAR; PG8_SCHED;
            PG8_LDB(B0, 1, 0); PG8_LDB(B1, 1, 1); PG8_SCHED; PG8_LDA(At, 1, 0); PG8_STAGE(PG8_SA(0, 1), a2 + hstep, voffA);
            PG8_WAIT_V(8); PG8_WAIT_L(0); PG8_BAR; PG8_MMA(0, 0, At, B0); PG8_MMA(0, 1, At, B1); PG8_BAR; PG8_SCHED;
            PG8_LDA(At, 1, 1); PG8_STAGE(PG8_SB(1, 0), b3, voffB); PG8_STAGE(PG8_SB(1, 1), b3 + hstep, voffB); PG8_STAGE(PG8_SA(1, 0), a3, voffA);
            PG8_WAIT_V(8); PG8_WAIT_L(0); PG8_BAR; PG8_MMA(1, 0, At, B0); PG8_MMA(1, 1, At, B1); PG8_BAR; PG8_SCHED;
            } else {
            PG8_LDB(B0, 0, 0); PG8_SCHED; PG8_LDA(At, 0, 0); PG8_STAGE(PG8_SA(1, 1), a1 + hstep, voffA);
            PG8_WAIT_L(8); PG8_BAR; PG8_WAIT_L(0); PG8_MMA(0, 0, At, B0); PG8_BAR; PG8_SCHED;
            PG8_LDB(B1, 0, 1); PG8_STAGE(PG8_SB(0, 0), b2, voffB);
            PG8_BAR; PG8_WAIT_L(0); PG8_MMA(0, 1, At, B1); PG8_BAR;
            PG8_LDA(At, 0, 1); PG8_STAGE(PG8_SA(0, 0), a2, voffA);
            PG8_BAR; PG8_WAIT_L(0); PG8_MMA(1, 0, At, B0); PG8_BAR; PG8_SCHED;
            PG8_STAGE(PG8_SB(0, 1), b2 + hstep, voffB);
            PG8_WAIT_V(6); PG8_BAR; PG8_MMA(1, 1, At, B1); PG8_BAR;
            PG8_LDB(B0, 1, 0); PG8_SCHED; PG8_LDA(At, 1, 0); PG8_STAGE(PG8_SA(0, 1), a2 + hstep, voffA);
            PG8_WAIT_L(8); PG8_BAR; PG8_WAIT_L(0); PG8_MMA(0, 0, At, B0); PG8_BAR; PG8_SCHED;
            PG8_LDB(B1, 1, 1); PG8_STAGE(PG8_SB(1, 0), b3, voffB);
            PG8_BAR; PG8_WAIT_L(0); PG8_MMA(0, 1, At, B1); PG8_BAR;
            PG8_LDA(At, 1, 1); PG8_STAGE(PG8_SA(1, 0), a3, voffA);
            PG8_BAR; PG8_WAIT_L(0); PG8_MMA(1, 0, At, B0); PG8_BAR; PG8_SCHED;
            PG8_STAGE(PG8_SB(1, 1), b3 + hstep, voffB);
            PG8_WAIT_V(6); PG8_BAR; PG8_MMA(1, 1, At, B1); PG8_BAR;
            }
        }
        if constexpr (ALIGN_EPI) { if (wr == 0) PG8_BAR; }
        if constexpr (!Epi::AFTER_DRAIN) { E(acc, cur, wr, wc, fr, fq, ui); S.done(cur); }
        if (!has_next) break;
#pragma unroll
        for (int a = 0; a < 2; ++a)
#pragma unroll
            for (int b = 0; b < 2; ++b)
#pragma unroll
                for (int m = 0; m < 4; ++m)
#pragma unroll
                    for (int n = 0; n < 2; ++n) acc[a][b][m][n] = (f32x4){0.f, 0.f, 0.f, 0.f};
        cur = nxt; cA = nA; cB = nB; ++ui;
        if constexpr (ALIGN_EPI) { if (wr == 1) PG8_BAR; }
    }
    PG8_WAIT_V(0);
    if constexpr (!ALIGN_EPI) { if (wr == 0) PG8_BAR; }
    PG8_BAR;
    if constexpr (Epi::AFTER_DRAIN) { E.fused(acc, cur, wr, wc, fr, fq, lds, wid, lane); S.done(cur); }
#undef PG8_SA
#undef PG8_SB
#undef PG8_STAGE
#undef PG8_LDA
#undef PG8_LDB
#undef PG8_MMA
#undef PG8_WAIT_V
#undef PG8_WAIT_L
#undef PG8_BAR
#undef PG8_SCHED
}
}
#define GAS __attribute__((address_space(1)))
#define LAS __attribute__((address_space(3)))
typedef unsigned short bf16;
typedef unsigned v4u __attribute__((ext_vector_type(4)));
typedef float f32x4 __attribute__((ext_vector_type(4)));
typedef short bf16x8 __attribute__((ext_vector_type(8)));
typedef GAS unsigned gu32;
typedef GAS unsigned long long gu64;
#define RLX_AGENT __ATOMIC_RELAXED, __HIP_MEMORY_SCOPE_AGENT
#define LDS_WAIT() asm volatile("s_waitcnt lgkmcnt(0)" ::: "memory")
#define VM_WAIT() asm volatile("s_waitcnt vmcnt(0)" ::: "memory")
__device__ __forceinline__ unsigned long long rt() { return __builtin_amdgcn_s_memrealtime(); }
__device__ __forceinline__ unsigned f2bf(float f) { unsigned u = __builtin_bit_cast(unsigned, f); return (u + 0x7fffu + ((u >> 16) & 1u)) >> 16; }
__device__ __forceinline__ unsigned pk2(float lo, float hi) { return f2bf(lo) | (f2bf(hi) << 16); }

#define XB_TMO      128
#define XB_XCNT(j)  (256  + 64 * (j))
#define XB_XSUB(j)  (1280 + 64 * (j))
#define XB_XGEN(j)  (2304 + 64 * (j))
#define XB_TOP      3328
#define XB_TOPGEN   3392
#define XCD_BAR_WORDS 3456
#define XB_SPIN_CAP (1u << 18)

__device__ __forceinline__ unsigned xb_ld(unsigned* p)              { return __hip_atomic_load(p, __ATOMIC_RELAXED, __HIP_MEMORY_SCOPE_AGENT); }
__device__ __forceinline__ unsigned xb_add(unsigned* p, unsigned v) { return __hip_atomic_fetch_add(p, v, __ATOMIC_RELAXED, __HIP_MEMORY_SCOPE_AGENT); }
__device__ __forceinline__ unsigned xb_xcc_id() { return (unsigned)__builtin_amdgcn_s_getreg((3 << 11) | 20) & 0xFu; }
#define XB_SPIN(cond, bar) do { unsigned _sp = 0; while (cond) { __builtin_amdgcn_s_sleep(1); \
    if ((++_sp & 255u) == 0u) { if (xb_ld(&(bar)[XB_TMO])) break; if (_sp > XB_SPIN_CAP) { atomicAdd(&(bar)[XB_TMO], 1u); break; } } } } while (0)

struct XcdBarrier {
    unsigned* bar; unsigned x;
    volatile LAS unsigned* st;
};

__device__ __forceinline__ XcdBarrier xcd_barrier_post(unsigned* bar, volatile LAS unsigned* st) {
    XcdBarrier b; b.bar = bar; b.x = xb_xcc_id(); b.st = st;
    if (threadIdx.x == 0) (void)xb_add(&bar[XB_XCNT(b.x)], 1u);
    return b;
}
__device__ __forceinline__ void xcd_barrier_complete(unsigned* bar, unsigned x, unsigned& nloc, unsigned& nx) {
    const unsigned G = gridDim.x * gridDim.y * gridDim.z;
    unsigned sum, cnt, mine, sp = 0u;
    for (;;) {
        sum = 0u; cnt = 0u; mine = 0u;
#pragma unroll
        for (unsigned j = 0; j < 16; ++j) { const unsigned c = xb_ld(&bar[XB_XCNT(j)]); sum += c; cnt += (c > 0u) ? 1u : 0u; mine = (j == x) ? c : mine; }
        if (sum == G) break;
        __builtin_amdgcn_s_sleep(1);
        if ((++sp & 255u) == 0u) { if (xb_ld(&bar[XB_TMO])) break; if (sp > XB_SPIN_CAP) { atomicAdd(&bar[XB_TMO], 1u); break; } }
    }
    nloc = mine > 0u ? mine : 1u; nx = cnt > 0u ? cnt : 1u;
}

__device__ __forceinline__ void xcd_barrier(const XcdBarrier& b) {
    asm volatile("s_waitcnt vmcnt(0)" ::: "memory");
    __syncthreads();
    if (threadIdx.x == 0) {
        unsigned* bar = b.bar;
        __builtin_amdgcn_s_waitcnt(0);
        unsigned nloc = b.st[0], nx = b.st[1];
        if (nloc == 0u) { xcd_barrier_complete(bar, b.x, nloc, nx); b.st[0] = nloc; b.st[1] = nx; }
        const unsigned old = xb_add(&bar[XB_XSUB(b.x)], 1u);
        const unsigned gen = old / nloc;
        if (old + 1u == (gen + 1u) * nloc) {
            __builtin_amdgcn_fence(__ATOMIC_RELEASE, "agent");
            asm volatile("s_waitcnt vmcnt(0)" ::: "memory");
            const unsigned og = xb_add(&bar[XB_TOP], 1u);
            const unsigned tg = og / nx;
            if (og + 1u == (tg + 1u) * nx) xb_add(&bar[XB_TOPGEN], 1u);
            else XB_SPIN(xb_ld(&bar[XB_TOPGEN]) == tg, bar);
            __builtin_amdgcn_fence(__ATOMIC_ACQUIRE, "agent");
            xb_add(&bar[XB_XGEN(b.x)], 1u);
            asm volatile("s_waitcnt vmcnt(0)" ::: "memory");
        } else {
            XB_SPIN(xb_ld(&bar[XB_XGEN(b.x)]) == gen, bar);
            __builtin_amdgcn_fence(__ATOMIC_ACQUIRE, "agent");
            asm volatile("s_waitcnt vmcnt(0)" ::: "memory");
        }
    }
    __syncthreads();
}
#include <hip/hip_bf16.h>
#include <cmath>
namespace attc {
using bf16=__hip_bfloat16;
using bf16x8=__attribute__((ext_vector_type(8)))short;
using s16x4=__attribute__((ext_vector_type(4)))short;
using f32x16=__attribute__((ext_vector_type(16)))float;
using u32x4=__attribute__((ext_vector_type(4)))unsigned;
constexpr int BATCH=8,NHEAD=16,SEQ=2048,D=64,QP=1536,KP=1536,OP=1024;
constexpr int NW=8,QBLK=32,QB=QBLK*NW,KVBLK=64,NQB=SEQ/QB;
constexpr int ATTN_UNIT_ROWS=QB;
__device__ __forceinline__ int crow(int r,int hi){return (r&3)+8*(r>>2)+4*hi;}
#define SBAR() __builtin_amdgcn_sched_barrier(0)
__device__ __forceinline__ void cmask(f32x16&p0,f32x16&p1,int jb,int qrel,int hi){
  const float NEG=-INFINITY; int kb=64*jb+4*hi;
  #pragma unroll
  for(int r=0;r<16;++r){int kv=kb+(r&3)+8*(r>>2); if(kv>qrel)p0[r]=NEG; if(kv+32>qrel)p1[r]=NEG;}
}

constexpr int NSLOT=3, SLOTB=8192;
constexpr int LDS_K=0, LDS_V=NSLOT*SLOTB, LDS_WS=2*NSLOT*SLOTB, LDS_OST=LDS_WS+NW*64*4, LDS_BYTES=LDS_OST+NW*4096;
constexpr float C2=0.125f*1.4426950408889634f;
__device__ __forceinline__ void glds16(const void*gsrc,unsigned lds_dst){unsigned keep;
  asm volatile("s_mov_b32 %0, m0\n\ts_mov_b32 m0, %2\n\ts_nop 0\n\tglobal_load_lds_dwordx4 %1, off\n\ts_mov_b32 m0, %0":"=&s"(keep):"v"(gsrc),"s"(lds_dst):"memory");}
__device__ __forceinline__ float max3f(float a,float b,float c){float r;asm("v_max3_f32 %0, %1, %2, %3":"=v"(r):"v"(a),"v"(b),"v"(c));return r;}
__device__ __forceinline__ float max2f(float a,float b){float r;asm("v_max_f32_e32 %0, %1, %2":"=v"(r):"v"(a),"v"(b));return r;}
__device__ __forceinline__ float fadd_s(float a,float b){float r;asm("v_add_f32_e32 %0, %1, %2":"=v"(r):"v"(a),"v"(b));return r;}
__device__ __forceinline__ float fsub_s(float a,float b){float r;asm("v_sub_f32_e32 %0, %1, %2":"=v"(r):"v"(a),"v"(b));return r;}
typedef float f32x2_t __attribute__((ext_vector_type(2))); typedef __bf16 bf16x2_t __attribute__((ext_vector_type(2)));
__device__ __forceinline__ unsigned cvtpk_s(float lo,float hi){f32x2_t v={lo,hi};bf16x2_t b=__builtin_convertvector(v,bf16x2_t);return __builtin_bit_cast(unsigned,b);}
#define WAIT_BAR(N) asm volatile("s_waitcnt vmcnt(" #N ") lgkmcnt(0)\n\ts_barrier":::"memory")

__device__ __forceinline__ void qkt(f32x16&p0,f32x16&p1,const char*Kslot,const bf16x8*qr,const f32x16&negm,int r32,int hi){
  const char*kb=Kslot+hi*1024+r32*16;
  #pragma unroll
  for(int d0=0;d0<4;++d0){
    const bf16x8 b0=*reinterpret_cast<const bf16x8*>(kb+d0*2048);
    const bf16x8 b1=*reinterpret_cast<const bf16x8*>(kb+d0*2048+512);
    if(d0==0){p0=__builtin_amdgcn_mfma_f32_32x32x16_bf16(b0,qr[0],negm,0,0,0);p1=__builtin_amdgcn_mfma_f32_32x32x16_bf16(b1,qr[0],negm,0,0,0);}
    else{p0=__builtin_amdgcn_mfma_f32_32x32x16_bf16(b0,qr[d0],p0,0,0,0);p1=__builtin_amdgcn_mfma_f32_32x32x16_bf16(b1,qr[d0],p1,0,0,0);}}
}
typedef __attribute__((address_space(3))) const char* lds_cptr;
typedef short v4i16_t __attribute__((ext_vector_type(4)));
__device__ __forceinline__ void kload8(bf16x8*kf,lds_cptr kp){
  kf[0]=*(const __attribute__((address_space(3))) bf16x8*)(kp);      kf[1]=*(const __attribute__((address_space(3))) bf16x8*)(kp+512);
  kf[2]=*(const __attribute__((address_space(3))) bf16x8*)(kp+2048); kf[3]=*(const __attribute__((address_space(3))) bf16x8*)(kp+2560);
  kf[4]=*(const __attribute__((address_space(3))) bf16x8*)(kp+4096); kf[5]=*(const __attribute__((address_space(3))) bf16x8*)(kp+4608);
  kf[6]=*(const __attribute__((address_space(3))) bf16x8*)(kp+6144); kf[7]=*(const __attribute__((address_space(3))) bf16x8*)(kp+6656);
}
__device__ __forceinline__ void kload2(bf16x8*kf,lds_cptr kp,int j){ kf[2*j]=*(const __attribute__((address_space(3))) bf16x8*)(kp+j*2048); kf[2*j+1]=*(const __attribute__((address_space(3))) bf16x8*)(kp+j*2048+512); }
__device__ __forceinline__ s16x4 vtr(lds_cptr p){ return __builtin_bit_cast(s16x4,__builtin_amdgcn_ds_read_tr16_b64_v4i16((__attribute__((address_space(3))) v4i16_t*)p)); }
__device__ __forceinline__ float rowmax(const f32x16&p0,const f32x16&p1){
  float a=max3f(p0[0],p0[1],p1[0]),b=max3f(p0[2],p0[3],p1[1]);a=max3f(a,p1[2],p1[3]);
  #pragma unroll
  for(int r=4;r<16;r+=4){a=max3f(a,p0[r],p0[r+1]);b=max3f(b,p0[r+2],p0[r+3]);a=max3f(a,p1[r],p1[r+1]);b=max3f(b,p1[r+2],p1[r+3]);}
  const float m=max2f(a,b);
  auto rr=__builtin_amdgcn_permlane32_swap(__float_as_uint(m),__float_as_uint(m),false,false);
  return max2f(__uint_as_float(rr[0]),__uint_as_float(rr[1]));
}
__device__ __forceinline__ void pv(f32x16*o,int vb,bf16x8 pa0,bf16x8 pa1,bf16x8 pa2,bf16x8 pa3){
  #pragma unroll
  for(int d0=0;d0<2;++d0){s16x4 lo[4],hi[4];
    #pragma unroll
    for(int ks=0;ks<4;++ks){
      asm volatile("ds_read_b64_tr_b16 %0,%1 offset:%c2":"=&v"(lo[ks]):"v"(vb),"i"(d0*4096+ks*1024):"memory");
      asm volatile("ds_read_b64_tr_b16 %0,%1 offset:%c2":"=&v"(hi[ks]):"v"(vb),"i"(d0*4096+ks*1024+512):"memory");}
    asm volatile("s_waitcnt lgkmcnt(0)":::"memory");SBAR();
    #define PK(k) (bf16x8){lo[k][0],lo[k][1],lo[k][2],lo[k][3],hi[k][0],hi[k][1],hi[k][2],hi[k][3]}
    o[d0]=__builtin_amdgcn_mfma_f32_32x32x16_bf16(pa0,PK(0),o[d0],0,0,0);
    o[d0]=__builtin_amdgcn_mfma_f32_32x32x16_bf16(pa1,PK(1),o[d0],0,0,0);
    o[d0]=__builtin_amdgcn_mfma_f32_32x32x16_bf16(pa2,PK(2),o[d0],0,0,0);
    o[d0]=__builtin_amdgcn_mfma_f32_32x32x16_bf16(pa3,PK(3),o[d0],0,0,0);
    #undef PK
  }
}

#ifndef ATTN_STORE16
#define ATTN_STORE16(p,v) (*(u32x4*)(p)=(v))
#endif
template<int THRL> __device__ __forceinline__ void attn_unit(int b,int h,int hk,int qb,const bf16*Q,const bf16*__restrict__ K,const bf16*__restrict__ V,bf16*O,char*shm){
  int tid_=threadIdx.x; asm volatile("":"+v"(tid_));
  const int tid=tid_,lane=tid&63,r32=lane&31,hi=lane>>5; const int wid=__builtin_amdgcn_readfirstlane(tid>>6);
  const long rowbase=(long)b*SEQ; const int q0=qb*QB;
  const bf16*Qw=Q+(rowbase+q0+wid*QBLK)*QP+h*D;
  const bf16*Kh=K+rowbase*KP+hk*D,*Vh=V+rowbase*KP+hk*D;
  const unsigned lds0=(unsigned)(uintptr_t)shm;
  float*wsf=(float*)(shm+LDS_WS)+wid*64;
  const bf16*ksrc=Kh+(long)lane*KP+wid*8;
  const bf16*vsrc=Vh+(long)(16*(wid&3)+(lane>>2))*KP+(wid>>2)*32+(lane&3)*8;
  const unsigned kdst=lds0+LDS_K+wid*1024, vdst=lds0+LDS_V+wid*1024;
  #define DMA_K(t,slot) glds16(ksrc+(long)(t)*KVBLK*KP,(unsigned)__builtin_amdgcn_readfirstlane(kdst+(slot)))
  #define DMA_V(t,slot) glds16(vsrc+(long)(t)*KVBLK*KP,(unsigned)__builtin_amdgcn_readfirstlane(vdst+(slot)))
  const int vb0=(int)(lds0+LDS_V)+((lane>>4)&1)*32+(lane&3)*8+(4*hi+((lane&15)>>2))*64;
  const char*Kbase=shm+LDS_K; bf16x8 kf[8];
  const lds_cptr shm3=(lds_cptr)shm; const lds_cptr kp0=shm3+LDS_K+hi*1024+r32*16; const lds_cptr vp0=shm3+LDS_V+((lane>>4)&1)*32+(lane&3)*8+(4*hi+((lane&15)>>2))*64;
  const int NT=SEQ/KVBLK;
  DMA_K(0,0);DMA_V(0,0);DMA_K(1,SLOTB);
  bf16x8 qr[4];
  #pragma unroll
  for(int d0=0;d0<4;++d0)qr[d0]=*reinterpret_cast<const bf16x8*>(&Qw[(long)r32*QP+d0*16+hi*8]);
  float mhat=0.f,l_reg=0.f;f32x16 o[2];o[0]=f32x16{};o[1]=f32x16{};f32x16 negm=f32x16{};asm volatile("":"+v"(negm));
  const int qrel=wid*QBLK+r32;
  #define CMASK(P0,P1,t) do{}while(0)
  bool resc=false;
  #define START(P0,P1) do{ const float rm=rowmax(P0,P1); resc=false; \
    { const float dl=rm; mhat=fadd_s(mhat,dl); \
      _Pragma("unroll") for(int r=0;r<16;++r){P0[r]=fsub_s(P0[r],dl);P1[r]=fsub_s(P1[r],dl);} \
      _Pragma("unroll") for(int r=0;r<16;++r)negm[r]=-mhat; asm volatile("":"+v"(negm)); } \
    _Pragma("unroll") for(int r=0;r<16;++r)P0[r]=__builtin_amdgcn_exp2f(P0[r]); }while(0)
  #define RESC() do{ if(resc){ asm volatile("s_waitcnt lgkmcnt(0)":::"memory"); \
      _Pragma("unroll") for(int d_=0;d_<2;++d_) _Pragma("unroll") for(int r=0;r<16;++r)o[d_][r]*=wsf[crow(r,hi)]; } }while(0)
  f32x16 pA0,pA1,pB0,pB1;
  int sl_prev=0,sl_cur=0,sl_next=SLOTB;
  #define ROT() do{sl_prev=sl_cur;sl_cur=sl_next;sl_next=(sl_next==(NSLOT-1)*SLOTB)?0:sl_next+SLOTB;}while(0)
  DMA_K(2,2*SLOTB);
  WAIT_BAR(3);
  qkt(pA0,pA1,Kbase,qr,negm,r32,hi);asm volatile("s_nop 15\n\ts_nop 7":"+v"(pA0),"+v"(pA1));CMASK(pA0,pA1,0);
  START(pA0,pA1);
  _Pragma("unroll") for(int r=0;r<16;++r)pA1[r]=__builtin_amdgcn_exp2f(pA1[r]);
  WAIT_BAR(0);
  DMA_K(3,0);DMA_V(1,SLOTB);
  ROT();
  kload8(kf,kp0+sl_cur);
  WAIT_BAR(2);
  s16x4 vlo[8],vhi[8]; u32x4 pw0,pw1,pw2,pw3;
  #define PKW(P,B) cvtpk_s(P[B],P[B+1])
  #define PAF(k) __builtin_bit_cast(bf16x8,pw##k)
  #define VFR(i) (bf16x8){vlo[i][0],vlo[i][1],vlo[i][2],vlo[i][3],vhi[i][0],vhi[i][1],vhi[i][2],vhi[i][3]}
  #define PIN(x) asm volatile("":"+v"(x))
  #define MX3(a,b,c) __builtin_fmaxf(__builtin_fmaxf((a),(b)),(c))
  #define GAPA(MF,A0,A1,A2,A3,W0,W1,PW) do{ MF; sacc+=A0; sacc+=A1; sacc+=A2; sacc+=A3; PIN(sacc); W0; W1; PIN(PW); SBAR(); }while(0)
  #define EX(v) __builtin_amdgcn_exp2f(v)
  #define GAPB(MF,X,B) do{ MF; X[B]=EX(X[B]); X[B+1]=EX(X[B+1]); X[B+2]=EX(X[B+2]); X[B+3]=EX(X[B+3]); PIN(X); SBAR(); }while(0)
  #define VRD(i) do{ vlo[i]=vtr(vp_+(((i)>>2)*4096+((i)&3)*1024)); vhi[i]=vtr(vp_+(((i)>>2)*4096+((i)&3)*1024+512)); }while(0)
  #define KRD(G,j) do{ if(G){ kload2(kf,kp0+sl_next,j); SBAR(); } }while(0)
  #define STEP(C0,C1,P0,P1,t,GK,GV,GL) do{ SBAR(); \
    const lds_cptr vp_=vp0+sl_prev; \
    VRD(0); SBAR(); float sacc=(P0[0]+P0[1]); \
    GAPA(C0=__builtin_amdgcn_mfma_f32_32x32x16_bf16(kf[0],qr[0],negm,0,0,0), P0[2],P0[3],P0[4],P0[5],     pw0[0]=PKW(P0,0), pw0[1]=PKW(P0,2), pw0); \
    VRD(4); SBAR(); GAPA(C1=__builtin_amdgcn_mfma_f32_32x32x16_bf16(kf[1],qr[0],negm,0,0,0), P0[6],P0[7],P0[8],P0[9],     pw0[2]=PKW(P0,4), pw0[3]=PKW(P0,6), pw0); \
    VRD(1); SBAR(); GAPA(C0=__builtin_amdgcn_mfma_f32_32x32x16_bf16(kf[2],qr[1],C0,0,0,0),   P0[10],P0[11],P0[12],P0[13], pw1[0]=PKW(P0,8), pw1[1]=PKW(P0,10), pw1); \
    VRD(5); SBAR(); GAPA(C1=__builtin_amdgcn_mfma_f32_32x32x16_bf16(kf[3],qr[1],C1,0,0,0),   P0[14],P0[15],P1[0],P1[1],   pw1[2]=PKW(P0,12),pw1[3]=PKW(P0,14), pw1); \
    VRD(2); SBAR(); GAPA(C0=__builtin_amdgcn_mfma_f32_32x32x16_bf16(kf[4],qr[2],C0,0,0,0),   P1[2],P1[3],P1[4],P1[5],     pw2[0]=PKW(P1,0), pw2[1]=PKW(P1,2), pw2); \
    VRD(6); SBAR(); GAPA(C1=__builtin_amdgcn_mfma_f32_32x32x16_bf16(kf[5],qr[2],C1,0,0,0),   P1[6],P1[7],P1[8],P1[9],     pw2[2]=PKW(P1,4), pw2[3]=PKW(P1,6), pw2); \
    VRD(3); SBAR(); GAPA(C0=__builtin_amdgcn_mfma_f32_32x32x16_bf16(kf[6],qr[3],C0,0,0,0),   P1[10],P1[11],P1[12],P1[13], pw3[0]=PKW(P1,8), pw3[1]=PKW(P1,10), pw3); \
    VRD(7); SBAR(); GAPA(C1=__builtin_amdgcn_mfma_f32_32x32x16_bf16(kf[7],qr[3],C1,0,0,0),   P1[14],P1[15],0.f,0.f,       pw3[2]=PKW(P1,12),pw3[3]=PKW(P1,14), pw3); \
    l_reg+=sacc; \
    if(GK){DMA_K((t)+3,sl_cur);} if(GV){DMA_V((t)+1,sl_next);} \
    CMASK(C0,C1,t); \
    { float a=MX3(C0[0],C0[1],C1[0]),b=MX3(C0[2],C0[3],C1[1]); a=MX3(a,C1[2],C1[3]); \
      _Pragma("unroll") for(int r=4;r<16;r+=4){a=MX3(a,C0[r],C0[r+1]);b=MX3(b,C0[r+2],C0[r+3]);a=MX3(a,C1[r],C1[r+1]);b=MX3(b,C1[r+2],C1[r+3]);} \
      float rm=__builtin_fmaxf(a,b); { auto rr=__builtin_amdgcn_permlane32_swap(__float_as_uint(rm),__float_as_uint(rm),false,false); rm=__builtin_fmaxf(__uint_as_float(rr[0]),__uint_as_float(rr[1])); } \
      resc=false; \
      if(__builtin_expect(__any(rm>(float)THRL),0)){ const float dl=__builtin_fmaxf(rm,0.f); mhat+=dl; \
        _Pragma("unroll") for(int r=0;r<16;++r){C0[r]-=dl;C1[r]-=dl;} \
        _Pragma("unroll") for(int r=0;r<16;++r)negm[r]=-mhat; asm volatile("":"+v"(negm)); \
        const float f=__builtin_amdgcn_exp2f(-dl); l_reg*=f; if(hi==0)wsf[r32]=f; resc=true; } } \
    SBAR(); \
    GAPB(o[0]=__builtin_amdgcn_mfma_f32_32x32x16_bf16(PAF(0),VFR(0),o[0],0,0,0), C0,0); \
    GAPB(o[1]=__builtin_amdgcn_mfma_f32_32x32x16_bf16(PAF(0),VFR(4),o[1],0,0,0), C0,4); \
    KRD(GL,0); GAPB(o[0]=__builtin_amdgcn_mfma_f32_32x32x16_bf16(PAF(1),VFR(1),o[0],0,0,0), C0,8); \
    KRD(GL,1); GAPB(o[1]=__builtin_amdgcn_mfma_f32_32x32x16_bf16(PAF(1),VFR(5),o[1],0,0,0), C0,12); \
    KRD(GL,2); GAPB(o[0]=__builtin_amdgcn_mfma_f32_32x32x16_bf16(PAF(2),VFR(2),o[0],0,0,0), C1,0); \
    KRD(GL,3); GAPB(o[1]=__builtin_amdgcn_mfma_f32_32x32x16_bf16(PAF(2),VFR(6),o[1],0,0,0), C1,4); \
    GAPB(o[0]=__builtin_amdgcn_mfma_f32_32x32x16_bf16(PAF(3),VFR(3),o[0],0,0,0), C1,8); \
    GAPB(o[1]=__builtin_amdgcn_mfma_f32_32x32x16_bf16(PAF(3),VFR(7),o[1],0,0,0), C1,12); \
    }while(0)
  int t=1;
  #undef CMASK
  #define CMASK(P0,P1,t) do{}while(0)
  for(;t+5<NT;t+=2){
    STEP(pB0,pB1,pA0,pA1,t,true,true,true);     WAIT_BAR(2); RESC(); ROT();
    STEP(pA0,pA1,pB0,pB1,t+1,true,true,true);   WAIT_BAR(2); RESC(); ROT();
  }
  #undef CMASK
  #define CMASK(P0,P1,t) do{}while(0)
  #define ENDW(tt) do{ if((tt)+3<NT){WAIT_BAR(2);} else if((tt)+2<NT){WAIT_BAR(1);} else {WAIT_BAR(0);} }while(0)
  for(;t+1<NT;t+=2){
    STEP(pB0,pB1,pA0,pA1,t,(t+3<NT),(t+1<NT),(t+1<NT));       ENDW(t);   RESC(); ROT();
    STEP(pA0,pA1,pB0,pB1,t+1,(t+4<NT),(t+2<NT),(t+2<NT));     ENDW(t+1); RESC(); ROT();
  }
  STEP(pB0,pB1,pA0,pA1,NT-1,false,false,false); RESC();
  { float sacc=pB0[0]+pB0[1]; _Pragma("unroll") for(int r=2;r<16;++r)sacc+=pB0[r]; _Pragma("unroll") for(int r=0;r<16;++r)sacc+=pB1[r]; l_reg+=sacc;
    pw0=(u32x4){PKW(pB0,0),PKW(pB0,2),PKW(pB0,4),PKW(pB0,6)};pw1=(u32x4){PKW(pB0,8),PKW(pB0,10),PKW(pB0,12),PKW(pB0,14)};pw2=(u32x4){PKW(pB1,0),PKW(pB1,2),PKW(pB1,4),PKW(pB1,6)};pw3=(u32x4){PKW(pB1,8),PKW(pB1,10),PKW(pB1,12),PKW(pB1,14)};
    SBAR(); pv(o,vb0+sl_cur,PAF(0),PAF(1),PAF(2),PAF(3)); }
  #undef PKW
  #undef PAF
  #undef VFR
  #undef PIN
  #undef MX3
  #undef GAPA
  #undef GAPB
  #undef EX
  #undef VRD
  #undef KRD
  #undef STEP
  #undef ENDW
  {auto rr=__builtin_amdgcn_permlane32_swap(__float_as_uint(l_reg),__float_as_uint(l_reg),false,false);l_reg=__uint_as_float(rr[0])+__uint_as_float(rr[1]);}
  if(hi==0)wsf[32+r32]=l_reg;asm volatile("s_waitcnt lgkmcnt(0)":::"memory");
  float rli[16];
  #pragma unroll
  for(int r=0;r<16;++r)rli[r]=__builtin_amdgcn_rcpf(wsf[32+crow(r,hi)]);
  bf16*Ow=O+(rowbase+q0+wid*QBLK)*OP+h*D;
  { bf16*stg=(bf16*)(shm+LDS_OST)+wid*2048;
    #pragma unroll
    for(int r=0;r<16;++r){const int orow=crow(r,hi);
      #pragma unroll
      for(int d0=0;d0<2;++d0)stg[orow*64+d0*32+r32]=__float2bfloat16(o[d0][r]*rli[r]);}
    asm volatile("s_waitcnt lgkmcnt(0)":::"memory");
    #pragma unroll
    for(int i=0;i<4;++i){const int row=i*8+(lane>>3),ch=lane&7; const u32x4 v=*(const u32x4*)(stg+row*64+ch*8); ATTN_STORE16(Ow+(long)row*OP+ch*8,v);} }
  asm volatile("s_waitcnt lgkmcnt(0)\n\ts_barrier":::"memory");
  #undef DMA_K
  #undef DMA_V
  #undef CMASK
  #undef START
  #undef RESC
  #undef ROT
}
constexpr int ATTN_LDS_BYTES=LDS_BYTES;
struct AttnTensors { const bf16* Q; const bf16* K; const bf16* V; bf16* O; };
template<int THRL=8> __device__ __forceinline__ void attn_phase(char*lds,const AttnTensors&T,int vcu){
  const int grp=vcu>>3,j=vcu&7,b=grp>>2,hk=grp&3,h=hk*4+(j>>1);
  for(int i=0;i<4;++i) attn_unit<THRL>(b,h,hk,(j&1)*4+i,T.Q,T.K,T.V,T.O,lds);
}
#undef SBAR
#undef WAIT_BAR
}

namespace att {
typedef short bf16x8 __attribute__((ext_vector_type(8)));
typedef short s16x4 __attribute__((ext_vector_type(4)));
typedef short v4i16_t __attribute__((ext_vector_type(4)));
typedef float f32x16 __attribute__((ext_vector_type(16)));
typedef unsigned u32x4 __attribute__((ext_vector_type(4)));
typedef unsigned u32x2 __attribute__((ext_vector_type(2)));
typedef float f32x2_t __attribute__((ext_vector_type(2))); typedef __bf16 bf16x2_t __attribute__((ext_vector_type(2)));
typedef unsigned short bf16_t;
#define ALAS __attribute__((address_space(3)))
constexpr float LOG2E = 1.4426950408889634f;
__device__ __forceinline__ int crow(int r, int hi) { return (r & 3) + 8 * (r >> 2) + 4 * hi; }
__device__ __forceinline__ unsigned cvtpk(float lo, float hi) { f32x2_t v = {lo, hi}; bf16x2_t b = __builtin_convertvector(v, bf16x2_t); return __builtin_bit_cast(unsigned, b); }
__device__ __forceinline__ s16x4 vtr(const ALAS unsigned char* p) { return __builtin_bit_cast(s16x4, __builtin_amdgcn_ds_read_tr16_b64_v4i16((ALAS v4i16_t*)p)); }
__device__ __forceinline__ int clampi(int v, int lo, int hi) { return v < lo ? lo : (v > hi ? hi : v); }

struct AttnP { const bf16_t* Q; const bf16_t* K; const bf16_t* V; int pitch; bf16_t* O; float* lse; const float* rpb; int dlog; int g; };

constexpr int WAVE_LDS = 8192;

template <int MODE>
__device__ __forceinline__ void attn_unit(const AttnP& P, int u, ALAS unsigned char* wl, int lane_) {
    int lane = lane_; asm volatile("" : "+v"(lane));
    const int q = lane & 31, hi = lane >> 5;
    int b, h, hk, qtok, tok0, tstep, kstr, nt, jt0;
    int rq = 0, cq = 0, kstart = 0;
    if (MODE == 0) {
        const int dlog = P.dlog, d = 1 << dlog, nblk = 64 >> dlog;
        h = u & 15; int rest = u >> 4; const int blk = rest & (nblk - 1); rest >>= (6 - dlog); const int r = rest & (d - 1); b = rest >> dlog; hk = h;
        const int i0 = 32 * blk, L = 2048 >> dlog;
        qtok = b * 2048 + ((i0 + q) << dlog) + r;
        const int jlo = (i0 < 64) ? ((64 - i0) >> 5) : 0; int jhi = (L - i0 + 64) >> 5; if (jhi > 5) jhi = 5;
        jt0 = jlo; nt = jhi - jlo;
        tok0 = b * 2048 + ((i0 - 64 + 32 * jlo) << dlog) + r; tstep = 32 << dlog; kstr = d;
    } else if (MODE == 1) {
        h = u & 15; const int rest = u >> 4; const int cb = rest & 3, rp = (rest >> 2) & 15; b = rest >> 6; hk = h;
        rq = 2 * rp + (q >> 4); cq = 16 * cb + (q & 15);
        qtok = b * 2048 + rq * 64 + cq;
        kstart = clampi(16 * cb - 8, 0, 32);
        const int rs0 = clampi(2 * rp - 4, 0, 24), rs1 = clampi(2 * rp - 3, 0, 24);
        jt0 = rs0; nt = rs1 + 8 - rs0;
        tok0 = b * 2048 + rs0 * 64 + kstart; tstep = 64; kstr = 1;
    } else {
        const int qblk = u & 63; h = (u >> 6) & 15; b = u >> 10; hk = h >> 2;
        qtok = b * 2048 + 32 * qblk + q; jt0 = 0; nt = 64; tok0 = b * 2048; tstep = 32; kstr = 1;
    }
    const int pitch = P.pitch;
    ALAS float* tab = (ALAS float*)(wl + 4096);
    float madd[16];
    if (MODE == 1) {
#pragma unroll
        for (int k = 0; k < 9; ++k) { const int i = lane + 64 * k; const int j = i - 16;
            if (i < 560) tab[i] = (i >= 512) ? -__builtin_inff() : ((j >= 0 && j < 465) ? P.rpb[h * 465 + j] * LOG2E : 0.f); }
        const int o_ = clampi(cq - 8, 0, 48) - kstart;
#pragma unroll
        for (int r = 0; r < 16; ++r) madd[r] = ((unsigned)(crow(r, hi) - o_) < 16u) ? 0.f : -__builtin_inff();
    }
    bf16x8 qf[4];
    { const bf16_t* qp = P.Q + (size_t)qtok * pitch + h * 64 + hi * 8;
#pragma unroll
      for (int ks = 0; ks < 4; ++ks) qf[ks] = *(const bf16x8*)(qp + 16 * ks); }
    const bf16_t* kp = P.K + hk * 64 + hi * 8 + (size_t)(tok0 + q * kstr) * pitch;
    const bf16_t* vp = P.V + hk * 64 + (lane & 7) * 8 + (size_t)(tok0 + (lane >> 3) * kstr) * pitch;
    const size_t tstepb = (size_t)tstep * pitch, vpiece = (size_t)8 * kstr * pitch;
    const int vwoff = ((lane & 7) >> 2) * 2048 + (lane >> 3) * 64 + (lane & 3) * 16;
    const ALAS unsigned char* vb = wl + (4 * hi + ((lane & 15) >> 2)) * 64 + ((lane >> 4) & 1) * 32 + (lane & 3) * 8;
    bf16x8 kn[4], vn[4], k2[4], v2[4];
#pragma unroll
    for (int ks = 0; ks < 4; ++ks) kn[ks] = *(const bf16x8*)(kp + 16 * ks);
#pragma unroll
    for (int i = 0; i < 4; ++i) vn[i] = *(const bf16x8*)(vp + i * vpiece);
    { const size_t adv = (nt > 1) ? tstepb : 0;
        kp += adv; vp += adv;
#pragma unroll
        for (int ks = 0; ks < 4; ++ks) k2[ks] = *(const bf16x8*)(kp + 16 * ks);
#pragma unroll
        for (int i = 0; i < 4; ++i) v2[i] = *(const bf16x8*)(vp + i * vpiece);
    }
    f32x16 o0 = {}, o1 = {};
    float mrun = -1e30f, l = 0.f;
    for (int t = 0; t < nt; ++t) {
        bf16x8 kc[4], vc[4];
#pragma unroll
        for (int i = 0; i < 4; ++i) { kc[i] = kn[i]; vc[i] = vn[i]; kn[i] = k2[i]; vn[i] = v2[i]; }
        { const size_t adv = (t + 2 < nt) ? tstepb : 0;
            kp += adv; vp += adv;
#pragma unroll
            for (int ks = 0; ks < 4; ++ks) k2[ks] = *(const bf16x8*)(kp + 16 * ks);
#pragma unroll
            for (int i = 0; i < 4; ++i) v2[i] = *(const bf16x8*)(vp + i * vpiece);
        }
#pragma unroll
        for (int i = 0; i < 4; ++i) *(ALAS bf16x8*)(wl + vwoff + i * 512) = vc[i];
        f32x16 p = {};
#pragma unroll
        for (int ks = 0; ks < 4; ++ks) p = __builtin_amdgcn_mfma_f32_32x32x16_bf16(kc[ks], qf[ks], p, 0, 0, 0);
        const float NEG = -__builtin_inff();
        if (MODE == 0) {
            const int jt = jt0 + t;
            if (jt == 0) {
#pragma unroll
                for (int r = 0; r < 16; ++r) if (crow(r, hi) < q) p[r] = NEG;
            }
            if (jt == 4) {
#pragma unroll
                for (int r = 0; r < 16; ++r) if (crow(r, hi) > q) p[r] = NEG;
            }
        } else if (MODE == 1) {
            const int kr = jt0 + t, rsq = clampi(rq - 4, 0, 24);
            const bool row_ok = (kr >= rsq) && (kr < rsq + 8);
            const ALAS float* brow = tab + (row_ok ? 16 + (kr - rq + 7) * 31 + (kstart - cq + 15) + 4 * hi : 512 + 4 * hi);
#pragma unroll
            for (int r = 0; r < 16; ++r) p[r] = (p[r] + brow[(r & 3) + 8 * (r >> 2)]) + madd[r];
        }
        float mx = p[0];
#pragma unroll
        for (int r = 1; r < 16; ++r) mx = fmaxf(mx, p[r]);
        mx = fmaxf(mx, __shfl_xor(mx, 32));
        const float mn = fmaxf(mrun, mx);
        const float alpha = __builtin_amdgcn_exp2f(mrun - mn);
        mrun = mn;
        float rs = 0.f;
#pragma unroll
        for (int r = 0; r < 16; ++r) { p[r] = __builtin_amdgcn_exp2f(p[r] - mn); rs += p[r]; }
        l = l * alpha + rs;
        if (__any(alpha != 1.0f)) {
#pragma unroll
            for (int r = 0; r < 16; ++r) { o0[r] *= alpha; o1[r] *= alpha; }
        }
        u32x4 w0, w1;
        w0.x = cvtpk(p[0], p[1]); w0.y = cvtpk(p[2], p[3]); w0.z = cvtpk(p[4], p[5]); w0.w = cvtpk(p[6], p[7]);
        w1.x = cvtpk(p[8], p[9]); w1.y = cvtpk(p[10], p[11]); w1.z = cvtpk(p[12], p[13]); w1.w = cvtpk(p[14], p[15]);
        const bf16x8 pf0 = __builtin_bit_cast(bf16x8, w0), pf1 = __builtin_bit_cast(bf16x8, w1);
#define ATT_VF(off) ({ const s16x4 lo_ = vtr(vb + (off)), hi_ = vtr(vb + (off) + 512); (bf16x8){lo_[0], lo_[1], lo_[2], lo_[3], hi_[0], hi_[1], hi_[2], hi_[3]}; })
        { const bf16x8 v00 = ATT_VF(0), v01 = ATT_VF(1024), v10 = ATT_VF(2048), v11 = ATT_VF(2048 + 1024);
          o0 = __builtin_amdgcn_mfma_f32_32x32x16_bf16(v00, pf0, o0, 0, 0, 0);
          o1 = __builtin_amdgcn_mfma_f32_32x32x16_bf16(v10, pf0, o1, 0, 0, 0);
          o0 = __builtin_amdgcn_mfma_f32_32x32x16_bf16(v01, pf1, o0, 0, 0, 0);
          o1 = __builtin_amdgcn_mfma_f32_32x32x16_bf16(v11, pf1, o1, 0, 0, 0); }
#undef ATT_VF
    }
    l += __shfl_xor(l, 32);
    const float inv = 1.0f / l;
    float wc_ = inv, wp_ = 0.f;
    if (MODE == 0) {
        float lse_new = mrun + __builtin_amdgcn_logf(l);
        if (P.g > 0) {
            const float lp = P.lse[(size_t)qtok * 16 + h];
            const float mm = fmaxf(lp, lse_new), ep = __builtin_amdgcn_exp2f(lp - mm), ec = __builtin_amdgcn_exp2f(lse_new - mm), den = ep + ec;
            wp_ = ep / den; wc_ = inv * (ec / den); lse_new = mm + __builtin_amdgcn_logf(den);
        }
        if (P.g < 2 && hi == 0) P.lse[(size_t)qtok * 16 + h] = lse_new;
    }
    bf16_t* op = P.O + (size_t)qtok * 1024 + h * 64 + 4 * hi;
#pragma unroll
    for (int db = 0; db < 2; ++db)
#pragma unroll
        for (int rr = 0; rr < 4; ++rr) {
            float v[4];
#pragma unroll
            for (int e = 0; e < 4; ++e) v[e] = (db == 0 ? o0[4 * rr + e] : o1[4 * rr + e]) * wc_;
            u32x2* dst = (u32x2*)(op + 32 * db + 8 * rr);
            if (MODE == 0 && P.g > 0) {
                const u32x2 pv = *dst;
                v[0] += wp_ * __uint_as_float(pv.x << 16); v[1] += wp_ * __uint_as_float(pv.x & 0xffff0000u);
                v[2] += wp_ * __uint_as_float(pv.y << 16); v[3] += wp_ * __uint_as_float(pv.y & 0xffff0000u);
            }
            u32x2 w; w.x = cvtpk(v[0], v[1]); w.y = cvtpk(v[2], v[3]);
            *dst = w;
        }
}
template <int MODE>
__device__ __forceinline__ void attn_phase(const AttnP& P, ALAS unsigned char* lds, int vcu, int wave, int lane) {
    ALAS unsigned char* wl = lds + wave * WAVE_LDS;
    for (int k = 0; k < 4; ++k) {
        int u;
        if (MODE == 2) { const int grp = vcu >> 3, j = vcu & 7, b = grp >> 2, kvh = grp & 3, h = kvh * 4 + (j >> 1), qblk = (j & 1) * 32 + k * 8 + wave; u = ((b * 16 + h) << 6) | qblk; }
        else u = vcu * 32 + k * 8 + wave;
        attn_unit<MODE>(P, u, wl, lane);
    }
}
}

namespace atta {
typedef short bf16x8 __attribute__((ext_vector_type(8)));
typedef short s16x4 __attribute__((ext_vector_type(4)));
typedef float f32x16 __attribute__((ext_vector_type(16)));
typedef unsigned u32x4 __attribute__((ext_vector_type(4)));
typedef unsigned u32x2 __attribute__((ext_vector_type(2)));
typedef unsigned short bf16_t;
constexpr int K_OFF = 0, V_OFF = 49152, ST_OFF = 98304, ST_ROW = 144, ST_WAVE = 32 * ST_ROW + 128, LDS_NEED = ST_OFF + 8 * ST_WAVE;
struct Params { const bf16_t* qkv; bf16_t* O; float* lse; int dlog; int g; };
using att::crow; using att::cvtpk; using att::vtr;

__device__ __forceinline__ void phase(const Params& P, ALAS unsigned char* lds, int vcu, int lane_) {
    int tid_ = threadIdx.x; asm volatile("" : "+v"(tid_));
    const int lane = tid_ & 63, w = __builtin_amdgcn_readfirstlane(tid_ >> 6), q = lane & 31, hi = lane >> 5;
    (void)lane_;
    const int dlog = P.dlog, L = 2048 >> dlog, g = P.g;
    const int npieces = (dlog == 4) ? 8 : 12;
    ALAS unsigned char* stg = lds + ST_OFF + w * ST_WAVE;
    ALAS float* stw = (ALAS float*)(stg + 32 * ST_ROW);
    bf16x8 qf[4]; u32x4 prevo[4]; float lprev = 0.f;
#define ATTA_DECODE(k) \
    const int u_ = vcu * 4 + (k), su = u_ & 7, h = (u_ >> 3) & 15, b = u_ >> 7; \
    const int rres = (dlog == 0) ? 0 : (dlog == 2 ? (su >> 1) : 2 * su + (w >> 2)); \
    const int I0 = (dlog == 0) ? 256 * su : (dlog == 2 ? 256 * (su & 1) : 0); \
    const int i0 = (dlog == 4) ? 32 * (w & 3) : I0 + 32 * w; \
    const int tb = (dlog == 4) ? 4 * (w >> 2) + (w & 3) - 2 : w;
#define ATTA_ISSUE(k) do { ATTA_DECODE(k) \
        for (int i = 0; i < npieces; ++i) { const int p = w + 8 * i, T = p >> 3, sub = p & 7; \
            const int res = (dlog == 0) ? 0 : (dlog == 2 ? (su >> 1) : 2 * su + (T >> 2)); \
            const int key0 = (dlog == 4) ? 32 * (T & 3) : I0 - 64 + 32 * T; \
            if (key0 >= 0 && key0 < L) { \
                if (sub < 4) { const int keyl = 8 * sub + (lane >> 3), cp = lane & 7; \
                    const bf16_t* src = P.qkv + (size_t)(b * 2048 + ((key0 + keyl) << dlog) + res) * 3072 + 1024 + h * 64 + ((cp ^ (keyl & 7)) * 8); \
                    __builtin_amdgcn_global_load_lds((const unsigned*)src, (ALAS unsigned*)(lds + K_OFF + T * 4096 + sub * 1024), 16, 0, 0); } \
                else { const int s2 = sub - 4, dh = s2 >> 1, kh = s2 & 1, keyl = 16 * kh + (lane >> 2), c4 = lane & 3; \
                    const bf16_t* src = P.qkv + (size_t)(b * 2048 + ((key0 + keyl) << dlog) + res) * 3072 + 2048 + h * 64 + dh * 32 + c4 * 8; \
                    __builtin_amdgcn_global_load_lds((const unsigned*)src, (ALAS unsigned*)(lds + V_OFF + T * 4096 + dh * 2048 + kh * 1024), 16, 0, 0); } } } \
        { const bf16_t* qp = P.qkv + (size_t)(b * 2048 + ((i0 + q) << dlog) + rres) * 3072 + h * 64 + hi * 8; \
          _Pragma("unroll") for (int ks = 0; ks < 4; ++ks) qf[ks] = *(const bf16x8*)(qp + 16 * ks); } \
        if (g > 0) { \
          _Pragma("unroll") for (int i = 0; i < 4; ++i) { const int row = 8 * i + (lane >> 3); \
              prevo[i] = *(const u32x4*)(P.O + (size_t)(b * 2048 + ((i0 + row) << dlog) + rres) * 1024 + h * 64 + (lane & 7) * 8); } \
          lprev = P.lse[(size_t)(b * 2048 + ((i0 + q) << dlog) + rres) * 16 + h]; } \
    } while (0)

    ATTA_ISSUE(0);
    for (int k = 0; k < 4; ++k) {
        asm volatile("s_waitcnt vmcnt(0)" ::: "memory"); __builtin_amdgcn_s_barrier(); asm volatile("" ::: "memory");
        ATTA_DECODE(k)
        f32x16 p[5];
        const float NEG = -__builtin_inff();
#pragma unroll
        for (int jt = 0; jt < 5; ++jt) {
            const int key0 = i0 - 64 + 32 * jt;
            if (key0 >= 0 && key0 < L) {
                const ALAS unsigned char* kt = lds + K_OFF + (tb + jt) * 4096 + q * 128;
                f32x16 acc = {};
#pragma unroll
                for (int ks = 0; ks < 4; ++ks) { const bf16x8 kf = *(const ALAS bf16x8*)(kt + (((2 * ks + hi) ^ (q & 7)) * 16)); acc = __builtin_amdgcn_mfma_f32_32x32x16_bf16(kf, qf[ks], acc, 0, 0, 0); }
                if (jt == 0) {
#pragma unroll
                    for (int r = 0; r < 16; ++r) if (crow(r, hi) < q) acc[r] = NEG;
                }
                if (jt == 4) {
#pragma unroll
                    for (int r = 0; r < 16; ++r) if (crow(r, hi) > q) acc[r] = NEG;
                }
                p[jt] = acc;
            } else {
#pragma unroll
                for (int r = 0; r < 16; ++r) p[jt][r] = NEG;
            }
        }
        float mx = p[2][0];
#pragma unroll
        for (int jt = 0; jt < 5; ++jt)
#pragma unroll
            for (int r = 0; r < 16; ++r) mx = fmaxf(mx, p[jt][r]);
        mx = fmaxf(mx, __shfl_xor(mx, 32));
        float l = 0.f;
#pragma unroll
        for (int jt = 0; jt < 5; ++jt)
#pragma unroll
            for (int r = 0; r < 16; ++r) { p[jt][r] = __builtin_amdgcn_exp2f(p[jt][r] - mx); l += p[jt][r]; }
        l += __shfl_xor(l, 32);
        f32x16 o0 = {}, o1 = {};
        const ALAS unsigned char* vb = lds + V_OFF + (4 * hi + ((lane & 15) >> 2)) * 64 + ((lane >> 4) & 1) * 32 + (lane & 3) * 8;
#pragma unroll
        for (int jt = 0; jt < 5; ++jt) {
            const int key0 = i0 - 64 + 32 * jt;
            if (key0 >= 0 && key0 < L) {
                const ALAS unsigned char* vt = vb + (tb + jt) * 4096;
                u32x4 w0, w1;
                w0.x = cvtpk(p[jt][0], p[jt][1]); w0.y = cvtpk(p[jt][2], p[jt][3]); w0.z = cvtpk(p[jt][4], p[jt][5]); w0.w = cvtpk(p[jt][6], p[jt][7]);
                w1.x = cvtpk(p[jt][8], p[jt][9]); w1.y = cvtpk(p[jt][10], p[jt][11]); w1.z = cvtpk(p[jt][12], p[jt][13]); w1.w = cvtpk(p[jt][14], p[jt][15]);
                const bf16x8 pf0 = __builtin_bit_cast(bf16x8, w0), pf1 = __builtin_bit_cast(bf16x8, w1);
#define ATTA_VF(off) ({ const s16x4 lo_ = vtr(vt + (off)), hi_ = vtr(vt + (off) + 512); (bf16x8){lo_[0], lo_[1], lo_[2], lo_[3], hi_[0], hi_[1], hi_[2], hi_[3]}; })
                const bf16x8 v00 = ATTA_VF(0), v01 = ATTA_VF(1024), v10 = ATTA_VF(2048), v11 = ATTA_VF(2048 + 1024);
#undef ATTA_VF
                o0 = __builtin_amdgcn_mfma_f32_32x32x16_bf16(v00, pf0, o0, 0, 0, 0);
                o1 = __builtin_amdgcn_mfma_f32_32x32x16_bf16(v10, pf0, o1, 0, 0, 0);
                o0 = __builtin_amdgcn_mfma_f32_32x32x16_bf16(v01, pf1, o0, 0, 0, 0);
                o1 = __builtin_amdgcn_mfma_f32_32x32x16_bf16(v11, pf1, o1, 0, 0, 0);
            }
        }
        const float inv = 1.0f / l;
        float wc_ = inv, wp_ = 0.f, lse_new = mx + __builtin_amdgcn_logf(l);
        if (g > 0) {
            const float mm = fmaxf(lprev, lse_new), ep = __builtin_amdgcn_exp2f(lprev - mm), ec = __builtin_amdgcn_exp2f(lse_new - mm), den = ep + ec;
            wp_ = ep / den; wc_ = inv * (ec / den); lse_new = mm + __builtin_amdgcn_logf(den);
        }
        if (g < 2 && hi == 0) P.lse[(size_t)(b * 2048 + ((i0 + q) << dlog) + rres) * 16 + h] = lse_new;
#pragma unroll
        for (int db = 0; db < 2; ++db)
#pragma unroll
            for (int rr = 0; rr < 4; ++rr) {
                u32x2 wv;
                wv.x = cvtpk((db == 0 ? o0[4 * rr + 0] : o1[4 * rr + 0]) * wc_, (db == 0 ? o0[4 * rr + 1] : o1[4 * rr + 1]) * wc_);
                wv.y = cvtpk((db == 0 ? o0[4 * rr + 2] : o1[4 * rr + 2]) * wc_, (db == 0 ? o0[4 * rr + 3] : o1[4 * rr + 3]) * wc_);
                *(ALAS u32x2*)(stg + q * ST_ROW + (32 * db + 8 * rr + 4 * hi) * 2) = wv;
            }
        if (hi == 0) stw[q] = wp_;
        u32x4 pv[4];
#pragma unroll
        for (int i = 0; i < 4; ++i) pv[i] = prevo[i];
        bf16_t* const obase = P.O + (size_t)(b * 2048 + rres) * 1024 + h * 64 + (lane & 7) * 8;
        const int orow0 = i0 + (lane >> 3);
        asm volatile("s_waitcnt lgkmcnt(0)" ::: "memory"); __builtin_amdgcn_s_barrier(); asm volatile("" ::: "memory");
        if (k + 1 < 4) ATTA_ISSUE(k + 1);
#pragma unroll
        for (int i = 0; i < 4; ++i) {
            const int row = 8 * i + (lane >> 3);
            const u32x4 sv = *(const ALAS u32x4*)(stg + row * ST_ROW + (lane & 7) * 16);
            u32x4 ov = sv;
            if (g > 0) {
                const float wr_ = stw[row];
#pragma unroll
                for (int e = 0; e < 4; ++e) {
                    const float a0 = __uint_as_float(sv[e] << 16) + wr_ * __uint_as_float(pv[i][e] << 16);
                    const float a1 = __uint_as_float(sv[e] & 0xffff0000u) + wr_ * __uint_as_float(pv[i][e] & 0xffff0000u);
                    ov[e] = cvtpk(a0, a1);
                }
            }
            *(u32x4*)(obase + ((size_t)((orow0 + 8 * i) << dlog)) * 1024) = ov;
        }
    }
    asm volatile("s_waitcnt vmcnt(0) lgkmcnt(0)" ::: "memory"); __builtin_amdgcn_s_barrier(); asm volatile("" ::: "memory");
#undef ATTA_DECODE
#undef ATTA_ISSUE
}
}

constexpr int NWAVES = 8;
#ifndef MK_N_LAUNCHES
#define MK_N_LAUNCHES 1
#endif
constexpr int N_PHASES = 30;
constexpr int N_LAUNCHES = MK_N_LAUNCHES;
constexpr int BATCH = 8, SEQ = 2048, D = 1024, FF = 4096, M = BATCH * SEQ;
constexpr size_t MiB = 1u << 20;
constexpr size_t WS_CTL = 0, CTL_ZERO_BYTES = 1 * MiB;
constexpr size_t WS_TAB = 1 * MiB;
constexpr size_t WS_RSS = 2 * MiB;
constexpr size_t WS_LSE = 3 * MiB;
constexpr size_t WS_XB = 121 * MiB;
constexpr size_t WS_ACT = 153 * MiB, WS_QKV = WS_ACT, WS_O = 249 * MiB, WS_H = WS_ACT, WS_END = 281 * MiB;
constexpr int CW_BAR = 4096;
constexpr int RING_OFF = 0, RING_BYTES = 131072;
constexpr int LDSCTL_OFF = 139264, MISC_OFF = LDSCTL_OFF + 320;
constexpr int TB_OFF = LDSCTL_OFF + 1024;
constexpr int LDS_BYTES = 147456;

struct Args { const float* in[29]; float* out; unsigned char* ws; int ph_lo, ph_hi; };
struct LayerDesc { const float *anorm, *win, *wout, *mnorm, *wup, *wdown, *rpb, *qn, *kn; int kind, nin; size_t o_in, o_out, o_up, o_down; };
__device__ __forceinline__ LayerDesc get_layer(const Args& a, int L) {
    LayerDesc d;
    if (L == 0)      { d.kind = 0; d.nin = 9216; d.o_in = 4 * MiB;  d.o_out = 22 * MiB;  d.o_up = 24 * MiB;  d.o_down = 32 * MiB;
                       d.anorm = a.in[1];  d.win = a.in[2];  d.wout = a.in[3];  d.mnorm = a.in[4];  d.wup = a.in[5];  d.wdown = a.in[6]; }
    else if (L == 1) { d.kind = 1; d.nin = 3072; d.o_in = 40 * MiB; d.o_out = 46 * MiB;  d.o_up = 48 * MiB;  d.o_down = 56 * MiB;
                       d.anorm = a.in[7];  d.win = a.in[8];  d.wout = a.in[10]; d.mnorm = a.in[11]; d.wup = a.in[12]; d.wdown = a.in[13]; }
    else if (L == 2) { d.kind = 2; d.nin = 1536; d.o_in = 64 * MiB; d.o_out = 67 * MiB;  d.o_up = 69 * MiB;  d.o_down = 77 * MiB;
                       d.anorm = a.in[14]; d.win = a.in[15]; d.wout = a.in[18]; d.mnorm = a.in[19]; d.wup = a.in[20]; d.wdown = a.in[21]; }
    else             { d.kind = 0; d.nin = 9216; d.o_in = 85 * MiB; d.o_out = 103 * MiB; d.o_up = 105 * MiB; d.o_down = 113 * MiB;
                       d.anorm = a.in[22]; d.win = a.in[23]; d.wout = a.in[24]; d.mnorm = a.in[25]; d.wup = a.in[26]; d.wdown = a.in[27]; }
    d.rpb = a.in[9]; d.qn = a.in[16]; d.kn = a.in[17];
    return d;
}

__device__ __forceinline__ float wave_sum(float v) {
#pragma unroll
    for (int o = 1; o < 64; o <<= 1) v += __shfl_xor(v, o);
    return v;
}
__device__ __forceinline__ void titem_load(const float* W, int N, const float* gain, int nblk, int item, int lane, f32x4 (&v)[8], float (&gk)[8]) {
    const int kb = item / nblk, nb = item - kb * nblk, k0 = 64 * kb, n0 = 32 * nb;
#pragma unroll
    for (int i = 0; i < 8; ++i) { const int kk = 8 * i + (lane >> 3), n4 = 4 * (lane & 7);
        v[i] = *(const GAS f32x4*)(W + (size_t)(k0 + kk) * N + n0 + n4); gk[i] = gain ? gain[k0 + kk] : 1.0f; }
}
__device__ __forceinline__ void titem_store(const f32x4 (&v)[8], const float (&gk)[8], int K, bf16* WT, bool perm, LAS float* scr, int nblk, int item, int lane) {
    const int kb = item / nblk, nb = item - kb * nblk, k0 = 64 * kb, n0 = 32 * nb;
#pragma unroll
    for (int i = 0; i < 8; ++i) { const int kk = 8 * i + (lane >> 3), n4 = 4 * (lane & 7);
        LAS float* s = scr + kk * 33 + n4; s[0] = v[i][0] * gk[i]; s[1] = v[i][1] * gk[i]; s[2] = v[i][2] * gk[i]; s[3] = v[i][3] * gk[i]; }
    LDS_WAIT(); asm volatile("" ::: "memory");
    const int c = lane & 7;
    const int nrow0 = perm ? ((n0 & ~255) | (((n0 >> 5) & 1) << 7) | (((n0 >> 6) & 3) << 5)) : n0;
#pragma unroll
    for (int j = 0; j < 4; ++j) { const int n = (lane >> 3) + 8 * j; const LAS float* s = scr + (8 * c) * 33 + n;
        v4u o; o.x = pk2(s[0 * 33], s[1 * 33]); o.y = pk2(s[2 * 33], s[3 * 33]); o.z = pk2(s[4 * 33], s[5 * 33]); o.w = pk2(s[6 * 33], s[7 * 33]);
        *(GAS v4u*)(WT + (size_t)(nrow0 + n) * K + k0 + 8 * c) = o; }
    LDS_WAIT(); asm volatile("" ::: "memory");
}
__device__ __forceinline__ void convert_matrix(const float* W, int K, int N, bf16* WT, const float* gain, bool perm, int rot, int gw, int ngw, LAS float* scr, int lane_) {
    int lane = lane_; asm volatile("" : "+v"(lane));
    const int nitems = (K / 64) * (N / 32), nblk = N / 32;
    int it = (gw - rot) % ngw; if (it < 0) it += ngw;
    f32x4 cv[8], nv[8]; float cg[8], ng[8];
    if (it < nitems) titem_load(W, N, gain, nblk, it, lane, cv, cg);
    while (it < nitems) {
        const int nx = it + ngw;
        if (nx < nitems) titem_load(W, N, gain, nblk, nx, lane, nv, ng);
        titem_store(cv, cg, K, WT, perm, scr, nblk, it, lane);
#pragma unroll
        for (int i = 0; i < 8; ++i) { cv[i] = nv[i]; cg[i] = ng[i]; }
        it = nx;
    }
}
#define CONVERT_WEIGHTS(MI_LO, MI_HI, GW_, NGW_) do { int rot_ = 0; \
        for (int mi = (MI_LO); mi < (MI_HI); ++mi) { \
            const LayerDesc d = get_layer(args, mi >> 2); const int j = mi & 3; \
            const float* W = j == 0 ? d.win : j == 1 ? d.wout : j == 2 ? d.wup : d.wdown; \
            const int K = j == 3 ? FF : D, N = j == 0 ? d.nin : j == 2 ? FF : D; \
            const float* gain = j == 0 ? d.anorm : j == 2 ? d.mnorm : nullptr; \
            bf16* WT = (bf16*)(ws + (j == 0 ? d.o_in : j == 1 ? d.o_out : j == 2 ? d.o_up : d.o_down)); \
            convert_matrix(W, K, N, WT, gain, j == 0, rot_, (GW_), (NGW_), scr, lane); \
            rot_ = (rot_ + (K / 64) * (N / 32)) % (NGW_); } } while (0)
__global__ void __launch_bounds__(NWAVES * 64, 2) mk_fwd(Args args) {
    extern __shared__ __attribute__((aligned(16))) unsigned char lds[];
    LAS unsigned char* const L3 = (LAS unsigned char*)lds;
    volatile LAS unsigned* const MISC = (volatile LAS unsigned*)(L3 + MISC_OFF);
    const int tid = threadIdx.x, lane = tid & 63, wave = __builtin_amdgcn_readfirstlane(tid >> 6);
    const int G = gridDim.x; const int bx = blockIdx.x; const int vcu = (G % 8 == 0) ? (bx % 8) * (G / 8) + bx / 8 : bx;
    unsigned char* const ws = args.ws;
    gu32* const ctl = (gu32*)(ws + WS_CTL);
    for (int u = tid; u < (LDS_BYTES - LDSCTL_OFF) / 4; u += NWAVES * 64) ((LAS unsigned*)(L3 + LDSCTL_OFF))[u] = 0u;
    __syncthreads();
    XcdBarrier bar; bar.bar = (unsigned*)(ctl + CW_BAR); bar.x = 0; bar.st = nullptr;
    if (N_LAUNCHES == 1) bar = xcd_barrier_post((unsigned*)(ctl + CW_BAR), MISC + 8);
    const int lo = args.ph_lo, hi = args.ph_hi;
    int ph = 0;
#ifndef PROBE_DUP_MASK
#define PROBE_DUP_MASK 0ull
#endif
#define PH_ON() (lo <= ph && ph < hi)
#ifndef PROBE_REPS
#define PROBE_REPS 2
#endif
#define PH_REP() (((PROBE_DUP_MASK >> ph) & 1ull) ? PROBE_REPS : 1)
#define PH_END() do { if (ph + 1 < hi) { if (N_LAUNCHES == 1) xcd_barrier(bar); } ++ph; } while (0)

#define tabs ((float*)(ws + WS_TAB))
#define invA (tabs)
#define invC (tabs + 32)
#define rss ((float*)(ws + WS_RSS))
#define lse ((float*)(ws + WS_LSE))
#define XB ((bf16*)(ws + WS_XB))
#define QKV ((bf16*)(ws + WS_QKV))
#define OB ((bf16*)(ws + WS_O))
#define HB ((bf16*)(ws + WS_H))
    const int gw = vcu * NWAVES + wave, NGW = G * NWAVES;

    if (PH_ON()) for (int rep_ = 0; rep_ < PH_REP(); ++rep_) {
        LAS float* scr = (LAS float*)(L3 + RING_OFF + wave * 16384);
        CONVERT_WEIGHTS(0, 12, gw, NGW);
        const float* x = args.in[0];
        { f32x4 v[4], vn[4];
          if (gw < M) { const GAS f32x4* xr = (const GAS f32x4*)(x + (size_t)gw * D) + lane;
#pragma unroll
              for (int j = 0; j < 4; ++j) v[j] = xr[64 * j]; }
          for (int m = gw; m < M; m += NGW) {
            if (m + NGW < M) { const GAS f32x4* xr = (const GAS f32x4*)(x + (size_t)(m + NGW) * D) + lane;
#pragma unroll
                for (int j = 0; j < 4; ++j) vn[j] = xr[64 * j]; }
            float s = 0.f;
            GAS unsigned long long* o8 = (GAS unsigned long long*)(XB + (size_t)m * D) + lane;
#pragma unroll
            for (int j = 0; j < 4; ++j) { const unsigned lo = pk2(v[j].x, v[j].y), hi2 = pk2(v[j].z, v[j].w); o8[64 * j] = (unsigned long long)lo | ((unsigned long long)hi2 << 32);
                const float r0 = __uint_as_float(lo << 16), r1 = __uint_as_float(lo & 0xffff0000u), r2 = __uint_as_float(hi2 << 16), r3 = __uint_as_float(hi2 & 0xffff0000u);
                s += (r0 * r0 + r1 * r1) + (r2 * r2 + r3 * r3); }
            s = wave_sum(s);
            if (lane < 4) rss[(size_t)m * 4 + lane] = (lane == 0) ? s : 0.f;
#pragma unroll
            for (int j = 0; j < 4; ++j) v[j] = vn[j];
          } }
        if (bx == 0 && tid < 64) {
            const int i = tid & 31;
            if (tid < 32) invA[i] = 1.0f / powf(10000.0f, (float)(2 * i) / 64.0f);
            else invC[i] = 1.0f / powf(10000.0f, (float)(2 * (i & 15)) / 32.0f);
        }
    }
    PH_END();

    for (int L = 0; L < 4; ++L) {
        const int kind = (L == 1) ? 1 : (L == 2) ? 2 : 0;
#define LD() const LayerDesc d = get_layer(args, L)
        if (kind == 0) {
            for (int g = 0; g < 3; ++g) {
                if (PH_ON()) for (int rep_ = 0; rep_ < PH_REP(); ++rep_) {
                    LD(); pg8::Gemm gm{XB, (const bf16*)(ws + d.o_in) + (size_t)g * 3072 * D, M, 3072, D}; pg8::StaticOrder S; S.init(M, 3072, G, bx);
                    pg8::TablePre TP; TP.load((LAS float*)(L3 + TB_OFF), S, rss, invA, nullptr, nullptr);
                    pg8::EpiQKV<0> E{QKV, 3072, (const LAS float*)(L3 + TB_OFF)};
                    pg8::gemm_phase<pg8::EpiQKV<0>, pg8::StaticOrder, true, true, pg8::TablePre>(L3 + RING_OFF, gm, S, E, TP);
                }
                PH_END();
                if (PH_ON()) for (int rep_ = 0; rep_ < PH_REP(); ++rep_) {
                    atta::Params P{QKV, OB, lse, g == 0 ? 0 : (g == 1 ? 2 : 4), g};
                    atta::phase(P, L3 + RING_OFF, vcu, lane);
                }
                PH_END();
            }
        } else if (kind == 1) {
            if (PH_ON()) for (int rep_ = 0; rep_ < PH_REP(); ++rep_) {
                LD(); pg8::Gemm gm{XB, (const bf16*)(ws + d.o_in), M, 3072, D}; pg8::StaticOrder S; S.init(M, 3072, G, bx);
                pg8::TablePre TP; TP.load((LAS float*)(L3 + TB_OFF), S, rss, nullptr, nullptr, nullptr);
                pg8::EpiQKV<1> E{QKV, 3072, (const LAS float*)(L3 + TB_OFF)};
                pg8::gemm_phase<pg8::EpiQKV<1>, pg8::StaticOrder, true, true, pg8::TablePre>(L3 + RING_OFF, gm, S, E, TP);
            }
            PH_END();
            if (PH_ON()) for (int rep_ = 0; rep_ < PH_REP(); ++rep_) {
                att::AttnP P{QKV, QKV + 1024, QKV + 2048, 3072, OB, lse, args.in[9], 0, 0};
                att::attn_phase<1>(P, L3 + RING_OFF, vcu, wave, lane);
            }
            PH_END();
        } else {
            if (PH_ON()) for (int rep_ = 0; rep_ < PH_REP(); ++rep_) {
                LD(); pg8::Gemm gm{XB, (const bf16*)(ws + d.o_in), M, 1536, D}; pg8::StaticOrder S; S.init(M, 1536, G, bx);
                pg8::TablePre TP; TP.load((LAS float*)(L3 + TB_OFF), S, rss, invC, args.in[16], args.in[17]);
                pg8::EpiQKV<2> E{QKV, 1536, (const LAS float*)(L3 + TB_OFF)};
                pg8::gemm_phase<pg8::EpiQKV<2>, pg8::StaticOrder, true, true, pg8::TablePre>(L3 + RING_OFF, gm, S, E, TP);
                if (bx >= 128) {
                    LAS float* scr = (LAS float*)(L3 + RING_OFF + wave * 16384);
                    const int gw2 = (bx - 128) * NWAVES + wave;
                    CONVERT_WEIGHTS(12, 16, gw2, 128 * NWAVES);
                }
            }
            PH_END();
            if (PH_ON()) for (int rep_ = 0; rep_ < PH_REP(); ++rep_) {
                const attc::AttnTensors AT{(const attc::bf16*)QKV, (const attc::bf16*)(QKV + 1024), (const attc::bf16*)(QKV + 1280), (attc::bf16*)OB};
                attc::attn_phase<8>((char*)lds + RING_OFF, AT, vcu);
            }
            PH_END();
        }
        if (PH_ON()) for (int rep_ = 0; rep_ < PH_REP(); ++rep_) {
            LD(); pg8::Gemm gm{OB, (const bf16*)(ws + d.o_out), M, D, D}; pg8::StaticOrder S; S.init(M, D, G, bx);
            pg8::EpiRes E{XB, rss};
            pg8::gemm_phase<pg8::EpiRes, pg8::StaticOrder, false, true>(L3 + RING_OFF, gm, S, E);
        }
        PH_END();
        if (PH_ON()) for (int rep_ = 0; rep_ < PH_REP(); ++rep_) {
            LD(); pg8::Gemm gm{XB, (const bf16*)(ws + d.o_up), M, FF, D}; pg8::StaticOrder S; S.init(M, FF, G, bx);
            pg8::TablePre TP; TP.load((LAS float*)(L3 + TB_OFF), S, rss, nullptr, nullptr, nullptr);
            pg8::EpiUp E{HB, FF, (const LAS float*)(L3 + TB_OFF)};
            pg8::gemm_phase<pg8::EpiUp, pg8::StaticOrder, true, true, pg8::TablePre>(L3 + RING_OFF, gm, S, E, TP);
        }
        PH_END();
        if (PH_ON()) for (int rep_ = 0; rep_ < PH_REP(); ++rep_) {
            LD(); pg8::Gemm gm{HB, (const bf16*)(ws + d.o_down), M, D, FF}; pg8::StaticOrder S; S.init(M, D, G, bx);
            pg8::EpiRes E{XB, rss};
            pg8::gemm_phase<pg8::EpiRes, pg8::StaticOrder, false, true>(L3 + RING_OFF, gm, S, E);
        }
        PH_END();
    }
    if (PH_ON()) for (int rep_ = 0; rep_ < PH_REP(); ++rep_) {
        const float* gf = args.in[28];
        for (int m = gw; m < M; m += NGW) {
            const float rstd = pg8::row_rstd(rss, m);
            const GAS unsigned long long* xr = (const GAS unsigned long long*)(XB + (size_t)m * D) + lane; GAS f32x4* orow = (GAS f32x4*)(args.out + (size_t)m * D) + lane; const GAS f32x4* gr = (const GAS f32x4*)gf + lane;
#pragma unroll
            for (int j = 0; j < 4; ++j) { const unsigned long long xv = xr[64 * j]; const unsigned lo = (unsigned)xv, hi2 = (unsigned)(xv >> 32); const f32x4 gg = gr[64 * j];
                f32x4 v; v.x = __uint_as_float(lo << 16); v.y = __uint_as_float(lo & 0xffff0000u); v.z = __uint_as_float(hi2 << 16); v.w = __uint_as_float(hi2 & 0xffff0000u);
                orow[64 * j] = v * rstd * gg; }
        }
    }
#undef PH_ON
#undef PH_END
#undef LD
}

extern "C" void kernel_launch(void* const* d_in, const int* in_sizes, int n_in, void* d_out, int out_size, void* d_ws, size_t ws_size, hipStream_t stream) {
    static int grid = 0;
    if (grid == 0) {
        if (n_in != 29 || in_sizes[0] != M * D || out_size != M * D || ws_size < WS_END) { fprintf(stderr, "kernel_launch: unexpected shapes / workspace (n_in %d, ws %zu); nothing launched\n", n_in, ws_size); grid = -1; return; }
        int dev = 0, cus = 0, per_cu = 0;
        if (hipGetDevice(&dev) != hipSuccess || hipDeviceGetAttribute(&cus, hipDeviceAttributeMultiprocessorCount, dev) != hipSuccess) { grid = -1; return; }
        if (hipFuncSetAttribute((const void*)mk_fwd, hipFuncAttributeMaxDynamicSharedMemorySize, LDS_BYTES) != hipSuccess) { fprintf(stderr, "kernel_launch: hipFuncSetAttribute failed\n"); grid = -1; return; }
        if (hipOccupancyMaxActiveBlocksPerMultiprocessor(&per_cu, (const void*)mk_fwd, NWAVES * 64, LDS_BYTES) != hipSuccess || per_cu < 1) fprintf(stderr, "kernel_launch: occupancy query reports %d\n", per_cu);
        (void)hipGetLastError();
        if (cus != 256) { fprintf(stderr, "kernel_launch: built for a 256-CU device, found %d; nothing launched\n", cus); grid = -1; return; }
        grid = 256;
    }
    if (grid < 0) return;
    if (hipMemsetAsync((char*)d_ws + WS_CTL, 0, CTL_ZERO_BYTES, stream) != hipSuccess) return;
    Args a{};
    for (int i = 0; i < 29; ++i) a.in[i] = (const float*)d_in[i];
    a.out = (float*)d_out; a.ws = (unsigned char*)d_ws;
    if (N_LAUNCHES == 1) { a.ph_lo = 0; a.ph_hi = N_PHASES; hipLaunchKernelGGL(mk_fwd, dim3(grid), dim3(NWAVES * 64), LDS_BYTES, stream, a); }
    else for (int p = 0; p < N_PHASES; ++p) { a.ph_lo = p; a.ph_hi = p + 1; hipLaunchKernelGGL(mk_fwd, dim3(grid), dim3(NWAVES * 64), LDS_BYTES, stream, a); }
}
```
